# Optimizing an MI355X kernel written in HIP

```python
import jax, jax.numpy as jnp
from jax import lax
import numpy as np

D_MODEL = 4096
BATCH = 2
SEQ = 8192
DEPTH = 2

GRID_W = 64
CTX_LEN = 256
HEAD_DIM = 128
BRANCH_W = D_MODEL // 4
N_BRANCH = 4
A_HEADS = BRANCH_W // HEAD_DIM
A_KV_HEADS = max(1, A_HEADS // 4)
A_WINDOW = 128
A_BLOCK = 128
NA_HEADS = BRANCH_W // HEAD_DIM
NA_ROWS = 8
NA_COLS = 16
NA_COL_BLOCK = 16
POOL_GROUPS = 4
POOL_G = BRANCH_W // POOL_GROUPS
POOL_WINDOWS = (2, 4, 8, 16)
FNET_GROUPS = 4
D_FF = ((8 * D_MODEL // 3 + 255) // 256) * 256
ROPE_BASE = 10000.0
EPS = 1e-6

A_Q_W = A_HEADS * HEAD_DIM
A_KV_W = A_KV_HEADS * HEAD_DIM
NA_W = NA_HEADS * HEAD_DIM
OFF_AK = A_Q_W
OFF_AV = OFF_AK + A_KV_W
OFF_NQ = OFF_AV + A_KV_W
OFF_NK = OFF_NQ + NA_W
OFF_NV = OFF_NK + NA_W
OFF_PU = OFF_NV + NA_W
OFF_FU = OFF_PU + BRANCH_W
OFF_GT = OFF_FU + BRANCH_W
IN_TOTAL = OFF_GT + N_BRANCH * D_MODEL
IN_SPLITS = (OFF_AK, OFF_AV, OFF_NQ, OFF_NK, OFF_NV, OFF_PU, OFF_FU, OFF_GT)

kernel_name = 'hybrid_gated_window_natten_pool_fnet_dit'

F32 = jnp.float32


def rms_norm(x, g):
    xf = x.astype(F32)
    y = xf * lax.rsqrt(jnp.mean(xf * xf, axis=-1, keepdims=True) + EPS)
    return (y * g.astype(F32)).astype(x.dtype)


def heads(u, n):
    return u.reshape(u.shape[0], u.shape[1], n, HEAD_DIM)


def axial_rope(x, rows, cols):
    half = x.shape[-1] // 2
    inv = jnp.power(ROPE_BASE, -jnp.arange(0, half, 2, dtype=F32) / half)

    def rot(xp, pos):
        ang = pos.astype(F32)[:, None] * inv[None, :]
        cos = jnp.cos(ang)[None, :, None, :].astype(x.dtype)
        sin = jnp.sin(ang)[None, :, None, :].astype(x.dtype)
        x1, x2 = xp[..., : half // 2], xp[..., half // 2:]
        return jnp.concatenate([x1 * cos - x2 * sin, x1 * sin + x2 * cos], axis=-1)

    return jnp.concatenate([rot(x[..., :half], rows), rot(x[..., half:], cols)], axis=-1)


def window_attention(q, k, v, ck, cv, sink):
    Bn, S, Hq, dh = q.shape
    Hkv = k.shape[2]
    G = Hq // Hkv
    L = ck.shape[1]
    nb = S // A_BLOCK
    scale = dh ** -0.5
    qb = q.reshape(Bn, nb, A_BLOCK, Hkv, G, dh)

    def band(z):
        zp = jnp.pad(z, ((0, 0), (A_BLOCK, A_BLOCK), (0, 0), (0, 0))).reshape(Bn, nb + 2, A_BLOCK, Hkv, dh)
        return jnp.concatenate([zp[:, :-2], zp[:, 1:-1], zp[:, 2:]], axis=2)

    kw, vw = band(k), band(v)
    qi = jnp.arange(A_BLOCK)[:, None]
    kj = jnp.arange(3 * A_BLOCK)[None, :]
    kpos = jnp.arange(nb)[:, None] * A_BLOCK - A_BLOCK + kj
    mask = (jnp.abs(kj - A_BLOCK - qi) <= A_WINDOW)[None] & ((kpos >= 0) & (kpos < S))[:, None, :]
    s_loc = jnp.einsum('bnqhgd,bnkhd->bhgnqk', qb, kw).astype(F32) * scale
    s_loc = jnp.where(mask, s_loc, -jnp.inf)
    s_ctx = jnp.einsum('bnqhgd,blhd->bhgnql', qb, ck).astype(F32) * scale
    s_sink = jnp.broadcast_to(sink.astype(F32).reshape(1, Hkv, G, 1, 1, 1), s_ctx.shape[:-1] + (1,))
    p = jax.nn.softmax(jnp.concatenate([s_loc, s_ctx, s_sink], axis=-1), axis=-1).astype(v.dtype)
    nloc = 3 * A_BLOCK
    o = (jnp.einsum('bhgnqk,bnkhd->bnqhgd', p[..., :nloc], vw)
         + jnp.einsum('bhgnql,blhd->bnqhgd', p[..., nloc:nloc + L], cv))
    return o.reshape(Bn, S, Hq * dh)


def neighbourhood_attention(q, k, v, ck, cv, rpb):
    Bn, S, H, dh = q.shape
    rows = S // GRID_W
    kr = min(NA_ROWS, rows)
    ncb = GRID_W // NA_COL_BLOCK
    halo = NA_COL_BLOCK + NA_COLS
    r = jnp.arange(rows)
    row_idx = jnp.clip(r - kr // 2, 0, rows - kr)[:, None] + jnp.arange(kr)[None, :]
    jb = jnp.arange(ncb)
    col_idx = jnp.clip(jb * NA_COL_BLOCK - NA_COLS // 2, 0, GRID_W - halo)[:, None] + jnp.arange(halo)[None, :]
    qcol = jb[:, None] * NA_COL_BLOCK + jnp.arange(NA_COL_BLOCK)[None, :]
    cstart = jnp.clip(qcol - NA_COLS // 2, 0, GRID_W - NA_COLS)
    kc = col_idx[:, None, :]
    in_win = (kc >= cstart[..., None]) & (kc < cstart[..., None] + NA_COLS)
    dr = row_idx - r[:, None] + NA_ROWS - 1
    dc = jnp.clip(kc - qcol[..., None] + NA_COLS - 1, 0, 2 * NA_COLS - 2)
    bias = rpb[:, dr[:, None, None, :, None], dc[None, :, :, None, :]].astype(F32)
    bias = jnp.where(in_win[None, None, :, :, None, :], bias, -jnp.inf)
    qg = q.reshape(Bn, rows, ncb, NA_COL_BLOCK, H, dh)
    ridx = row_idx[:, None, :, None]
    cidx = col_idx[None, :, None, :]
    kn = k.reshape(Bn, rows, GRID_W, H, dh)[:, ridx, cidx]
    vn = v.reshape(Bn, rows, GRID_W, H, dh)[:, ridx, cidx]
    scale = dh ** -0.5
    nloc = kr * halo
    s_loc = jnp.einsum('brjqhd,brjkchd->bhrjqkc', qg, kn).astype(F32) * scale + bias[None]
    s_loc = s_loc.reshape(Bn, H, rows, ncb, NA_COL_BLOCK, nloc)
    s_ctx = jnp.einsum('brjqhd,blhd->bhrjql', qg, ck).astype(F32) * scale
    p = jax.nn.softmax(jnp.concatenate([s_loc, s_ctx], axis=-1), axis=-1).astype(v.dtype)
    p_loc = p[..., :nloc].reshape(Bn, H, rows, ncb, NA_COL_BLOCK, kr, halo)
    o = (jnp.einsum('bhrjqkc,brjkchd->brjqhd', p_loc, vn)
         + jnp.einsum('bhrjql,blhd->brjqhd', p[..., nloc:], cv))
    return o.reshape(Bn, S, H * dh)


def context_attention(q, k, v, sink):
    Bn, L, Hq, dh = q.shape
    Hkv = k.shape[2]
    G = Hq // Hkv
    qg = q.reshape(Bn, L, Hkv, G, dh)
    s = jnp.einsum('blhgd,bmhd->bhglm', qg, k).astype(F32) * (dh ** -0.5)
    if sink is None:
        p = jax.nn.softmax(s, axis=-1)
    else:
        s_sink = jnp.broadcast_to(sink.astype(F32).reshape(1, Hkv, G, 1, 1), s.shape[:-1] + (1,))
        p = jax.nn.softmax(jnp.concatenate([s, s_sink], axis=-1), axis=-1)[..., :L]
    o = jnp.einsum('bhglm,bmhd->blhgd', p.astype(v.dtype), v)
    return o.reshape(Bn, L, Hq * dh)


def multiscale_pool(u, w_pool, scale):
    Bn, N, C = u.shape
    ug = u.astype(F32).reshape(Bn, N, POOL_GROUPS, POOL_G)
    csum = jnp.concatenate([jnp.zeros_like(ug[:, :1]), jnp.cumsum(ug, axis=1)], axis=1)
    t = jnp.arange(N)[:, None]
    win = jnp.array(POOL_WINDOWS, dtype=jnp.int32)[None, :]
    lo = jnp.clip(t - win // 2, 0, N)
    hi = jnp.clip(t - win // 2 + win, 0, N)
    grp = jnp.arange(POOL_GROUPS)[None, :]
    mean = (csum[:, hi, grp] - csum[:, lo, grp]) / (hi - lo).astype(F32)[None, :, :, None]
    y = jnp.einsum('bngc,gcd->bngd', (mean - ug).astype(u.dtype), w_pool)
    return y.reshape(Bn, N, C) * scale


def fourier_mix(u, w):
    Bn, N, C = u.shape
    ug = u.astype(F32).reshape(Bn, N, FNET_GROUPS, C // FNET_GROUPS).transpose(0, 2, 1, 3)
    y = jnp.fft.fft2(ug, norm='ortho').real
    y = y.transpose(0, 2, 1, 3).reshape(Bn, N, C).astype(u.dtype)
    return y @ w


def gated_merge(ys, gate_logits, w_branch, w_out):
    merged = None
    for i in range(N_BRANCH):
        g = jax.nn.sigmoid(gate_logits[..., i * D_MODEL:(i + 1) * D_MODEL])
        term = g * (ys[i] @ w_branch[i])
        merged = term if merged is None else merged + term
    return merged @ w_out


def conv_ffn(h, w_gate, w_val, conv_w, conv_b, w_down):
    a = h @ w_gate
    zero = jnp.zeros_like(a[:, :1])
    a = (jnp.concatenate([zero, a[:, :-1]], axis=1) * conv_w[0] + a * conv_w[1]
         + jnp.concatenate([a[:, 1:], zero], axis=1) * conv_w[2] + conv_b)
    return (jax.nn.silu(a) * (h @ w_val)) @ w_down


def setup_inputs(seed: int = 0) -> dict:
    key = jax.random.key(seed)
    ks = jax.random.split(key, 24)
    nrm = jax.random.normal
    D = D_MODEL
    return {
        'x': nrm(ks[0], (BATCH, SEQ, D), F32),
        'c': nrm(ks[1], (BATCH, D), F32),
        'ctx': nrm(ks[2], (BATCH, CTX_LEN, D), F32),
        'c_ctx': nrm(ks[3], (D,), F32),
        'w_mod': nrm(ks[4], (DEPTH, D, 6 * D), F32) * (0.5 * D ** -0.5),
        'b_mod': nrm(ks[5], (DEPTH, 6 * D), F32) * 0.02,
        'g_mix': 1.0 + 0.05 * nrm(ks[6], (DEPTH, D), F32),
        'w_in': nrm(ks[7], (DEPTH, D, IN_TOTAL), F32) * D ** -0.5,
        'a_sink': nrm(ks[8], (DEPTH, A_HEADS), F32),
        'na_rpb': 0.5 * nrm(ks[9], (DEPTH, NA_HEADS, 2 * NA_ROWS - 1, 2 * NA_COLS - 1), F32),
        'w_pool': nrm(ks[10], (DEPTH, POOL_GROUPS, POOL_G, POOL_G), F32) * POOL_G ** -0.5,
        'pool_scale': 1.0 + 0.1 * nrm(ks[11], (DEPTH, BRANCH_W), F32),
        'w_fnet': nrm(ks[12], (DEPTH, BRANCH_W, BRANCH_W), F32) * BRANCH_W ** -0.5,
        'w_branch': nrm(ks[13], (DEPTH, N_BRANCH, BRANCH_W, D), F32) * BRANCH_W ** -0.5,
        'w_out': nrm(ks[14], (DEPTH, D, D), F32) * D ** -0.5,
        'g_ffn': 1.0 + 0.05 * nrm(ks[15], (DEPTH, D), F32),
        'w_ff_gate': nrm(ks[16], (DEPTH, D, D_FF), F32) * D ** -0.5,
        'w_ff_val': nrm(ks[17], (DEPTH, D, D_FF), F32) * D ** -0.5,
        'ff_conv_w': nrm(ks[18], (DEPTH, 3, D_FF), F32) * 3 ** -0.5,
        'ff_conv_b': 0.02 * nrm(ks[19], (DEPTH, D_FF), F32),
        'w_ff_down': nrm(ks[20], (DEPTH, D_FF, D), F32) * D_FF ** -0.5,
        'g_final': 1.0 + 0.05 * nrm(ks[21], (D,), F32),
    }


def reference(x, c, ctx, c_ctx, w_mod, b_mod, g_mix, w_in, a_sink, na_rpb, w_pool, pool_scale, w_fnet,
              w_branch, w_out, g_ffn, w_ff_gate, w_ff_val, ff_conv_w, ff_conv_b, w_ff_down, g_final):
    S = x.shape[1]
    t = jnp.arange(S)
    grid_row, grid_col = t // GRID_W, t % GRID_W
    cond = jax.nn.silu(c)
    cond_ctx = jax.nn.silu(c_ctx)
    xc = ctx
    for l in range(DEPTH):
        last = l == DEPTH - 1
        sh1, sc1, gt1, sh2, sc2, gt2 = jnp.split((cond @ w_mod[l] + b_mod[l])[:, None, :], 6, axis=-1)
        csh1, csc1, cgt1, csh2, csc2, cgt2 = jnp.split(cond_ctx @ w_mod[l] + b_mod[l], 6, axis=-1)
        h = rms_norm(x, g_mix[l]) * (1 + sc1) + sh1
        hc = rms_norm(xc, g_mix[l]) * (1 + csc1) + csh1
        aq, ak, av, nq, nk, nv, pool_u, fnet_u, gate_l = jnp.split(h @ w_in[l], IN_SPLITS, axis=-1)
        if last:
            cak, cav = jnp.split(hc @ w_in[l][:, OFF_AK:OFF_NQ], 2, axis=-1)
            cnk, cnv = jnp.split(hc @ w_in[l][:, OFF_NK:OFF_PU], 2, axis=-1)
        else:
            caq, cak, cav, cnq, cnk, cnv, cpool_u, cfnet_u, cgate_l = jnp.split(hc @ w_in[l], IN_SPLITS, axis=-1)
        ya = window_attention(axial_rope(heads(aq, A_HEADS), grid_row, grid_col),
                              axial_rope(heads(ak, A_KV_HEADS), grid_row, grid_col),
                              heads(av, A_KV_HEADS), heads(cak, A_KV_HEADS), heads(cav, A_KV_HEADS), a_sink[l])
        yn = neighbourhood_attention(heads(nq, NA_HEADS), heads(nk, NA_HEADS), heads(nv, NA_HEADS),
                                     heads(cnk, NA_HEADS), heads(cnv, NA_HEADS), na_rpb[l])
        yp = multiscale_pool(pool_u, w_pool[l], pool_scale[l])
        yf = fourier_mix(fnet_u, w_fnet[l])
        x = x + gt1 * gated_merge((ya, yn, yp, yf), gate_l, w_branch[l], w_out[l])
        h2 = rms_norm(x, g_ffn[l]) * (1 + sc2) + sh2
        x = x + gt2 * conv_ffn(h2, w_ff_gate[l], w_ff_val[l], ff_conv_w[l], ff_conv_b[l], w_ff_down[l])
        if not last:
            cya = context_attention(heads(caq, A_HEADS), heads(cak, A_KV_HEADS), heads(cav, A_KV_HEADS), a_sink[l])
            cyn = context_attention(heads(cnq, NA_HEADS), heads(cnk, NA_HEADS), heads(cnv, NA_HEADS), None)
            cyp = multiscale_pool(cpool_u, w_pool[l], pool_scale[l])
            cyf = fourier_mix(cfnet_u, w_fnet[l])
            xc = xc + cgt1 * gated_merge((cya, cyn, cyp, cyf), cgate_l, w_branch[l], w_out[l])
            hc2 = rms_norm(xc, g_ffn[l]) * (1 + csc2) + csh2
            xc = xc + cgt2 * conv_ffn(hc2, w_ff_gate[l], w_ff_val[l], ff_conv_w[l], ff_conv_b[l], w_ff_down[l])
    return rms_norm(x, g_final)
```

```cpp
#include <hip/hip_runtime.h>
#include <cstdio>
#include <cstdint>

#ifndef MK_N_LAUNCHES
#define MK_N_LAUNCHES 1
#endif

#define GAS __attribute__((address_space(1)))
#define LAS __attribute__((address_space(3)))
typedef unsigned short bf16;
typedef short bf16x8 __attribute__((ext_vector_type(8)));
typedef short s16x4 __attribute__((ext_vector_type(4)));
typedef float f32x4 __attribute__((ext_vector_type(4)));
typedef float f32x2 __attribute__((ext_vector_type(2)));
typedef float f32x16 __attribute__((ext_vector_type(16)));
typedef unsigned u32x4 __attribute__((ext_vector_type(4)));
typedef unsigned u32x2 __attribute__((ext_vector_type(2)));
typedef int i32x4 __attribute__((ext_vector_type(4)));
typedef GAS unsigned gu32;

constexpr int DM = 4096, SEQ = 8192, NBATCH = 2, CTXL = 256;
constexpr int TL = NBATCH * SEQ;
constexpr int TC = NBATCH * CTXL;
constexpr int T = TL + TC;
constexpr int NIN = 23040, DFF = 11008, NUP = 2 * DFF, ACTW = 6656, GW = 16384;
constexpr int OFF_AQ = 0, OFF_AK = 1024, OFF_AV = 1280, OFF_NQ = 1536, OFF_NK = 2560, OFF_NV = 3584, OFF_PU = 4608, OFF_FU = 5632;
constexpr int MODW = 6 * DM;
constexpr float QSCALE = 0.08838834764831845f * 1.4426950408889634f;
constexpr float LOG2E = 1.4426950408889634f;
constexpr float EPS = 1e-6f;

constexpr size_t MiB = 1u << 20;
constexpr size_t WS_CTL = 0, CTL_ZERO_BYTES = 2 * MiB;
constexpr size_t WS_MOD = 1 * MiB;
constexpr size_t WS_CM3 = 1 * MiB + 896 * 1024;
constexpr size_t WS_CM2 = 1 * MiB + 768 * 1024;
constexpr size_t WS_CM = 1 * MiB + 640 * 1024;
constexpr size_t WS_ROPE = 2 * MiB;
constexpr size_t WS_TAB1 = 2 * MiB + 256 * 1024;
constexpr size_t WS_DFTC = 2 * MiB + 512 * 1024;
constexpr size_t WS_WPOOLB = 3 * MiB;
constexpr size_t WS_WFNETB = 4 * MiB;
constexpr size_t WS_WB2ST = 8 * MiB;
constexpr size_t WS_WB3T = 24 * MiB;
constexpr size_t WS_DFTA = 40 * MiB;
constexpr size_t WS_WL = 296 * MiB, WL_STRIDE = 504 * MiB;
constexpr size_t WL_IN = 0, WL_M = 180 * MiB, WL_OUT = 212 * MiB, WL_UP = 244 * MiB, WL_DN = 416 * MiB;
constexpr size_t WS_H = 1306 * MiB;
constexpr size_t WS_ACT = 1440 * MiB;
constexpr size_t WS_MG = WS_ACT;
constexpr size_t WS_G = 1656 * MiB;
constexpr size_t WS_U = WS_G;
constexpr size_t WS_YCAT = 2184 * MiB;
constexpr size_t WS_ZT = 2316 * MiB;
constexpr size_t WS_ZTC = 2380 * MiB;
constexpr size_t WS_X = 2382 * MiB;
constexpr size_t WS_SLAB = 2648 * MiB;
constexpr size_t WS_H8 = 2712 * MiB;
constexpr size_t WS_WG8 = 2780 * MiB;
constexpr size_t WS_SH = 2908 * MiB;
constexpr size_t WS_SW = 2908 * MiB + 256 * 1024;
constexpr size_t WS_WGA8 = 2910 * MiB;
constexpr size_t WS_SWG = 2908 * MiB + 512 * 1024;
constexpr size_t WS_WV8 = 172 * MiB;
constexpr size_t WS_SWUP = 2908 * MiB + 768 * 1024;
constexpr size_t WS_SWV = 2908 * MiB + 640 * 1024;
constexpr size_t WS_PART = 2998 * MiB;
constexpr size_t WS_END = 3008 * MiB;

constexpr int CW_TMO = 0;
constexpr int CW_BAR = 4096;

constexpr int RING_BYTES = 131072;
constexpr int LDSCTL_OFF = RING_BYTES, MISC_OFF = LDSCTL_OFF + 320;
constexpr int LDS_BYTES = 147456;
constexpr int NWAVES = 8;

#define RLX_AGENT __ATOMIC_RELAXED, __HIP_MEMORY_SCOPE_AGENT
#define LDS_WAIT() asm volatile("s_waitcnt lgkmcnt(0)" ::: "memory")
#define VM_WAIT() asm volatile("s_waitcnt vmcnt(0)" ::: "memory")
typedef __bf16 bf16x2_t __attribute__((ext_vector_type(2)));
__device__ __forceinline__ unsigned cvt_pk_bf16(float lo, float hi) { f32x2 f = {lo, hi}; bf16x2_t v = __builtin_convertvector(f, bf16x2_t); return __builtin_bit_cast(unsigned, v); }
__device__ __forceinline__ float bf2f(unsigned short b) { return __builtin_bit_cast(float, ((unsigned)b) << 16); }
__device__ __forceinline__ float bflo(unsigned w) { return __builtin_bit_cast(float, w << 16); }
__device__ __forceinline__ float bfhi(unsigned w) { return __builtin_bit_cast(float, w & 0xffff0000u); }
__device__ __forceinline__ float fast_exp2(float x) { return __builtin_amdgcn_exp2f(x); }
__device__ __forceinline__ float fast_rcp(float x) { return __builtin_amdgcn_rcpf(x); }
__device__ __forceinline__ float sigmoidf_(float x) { return fast_rcp(1.0f + fast_exp2(-x * LOG2E)); }
__device__ __forceinline__ float wave_sum(float v) {
#pragma unroll
    for (int o = 1; o < 64; o <<= 1) v += __shfl_xor(v, o);
    return v;
}

#define XB_TMO      128
#define XB_XCNT(j)  (256  + 64 * (j))
#define XB_XSUB(j)  (1280 + 64 * (j))
#define XB_XGEN(j)  (2304 + 64 * (j))
#define XB_TOP      3328
#define XB_TOPGEN   3392
#define XCD_BAR_WORDS 3456
#define XB_SPIN_CAP (1u << 18)
__device__ __forceinline__ unsigned xb_ld(unsigned* p)              { return __hip_atomic_load(p, __ATOMIC_RELAXED, __HIP_MEMORY_SCOPE_AGENT); }
__device__ __forceinline__ unsigned xb_add(unsigned* p, unsigned v) { return __hip_atomic_fetch_add(p, v, __ATOMIC_RELAXED, __HIP_MEMORY_SCOPE_AGENT); }
__device__ __forceinline__ unsigned xb_xcc_id() { return (unsigned)__builtin_amdgcn_s_getreg((3 << 11) | 20) & 0xFu; }
#define XB_SPIN(cond, bar) do { unsigned _sp = 0; while (cond) { __builtin_amdgcn_s_sleep(1); \
    if ((++_sp & 255u) == 0u) { if (xb_ld(&(bar)[XB_TMO])) break; if (_sp > XB_SPIN_CAP) { atomicAdd(&(bar)[XB_TMO], 1u); break; } } } } while (0)
struct XcdBarrier { unsigned* bar; unsigned x; volatile LAS unsigned* st; };
__device__ __forceinline__ XcdBarrier xcd_barrier_post(unsigned* bar, volatile LAS unsigned* st) {
    XcdBarrier b; b.bar = bar; b.x = xb_xcc_id(); b.st = st;
    if (threadIdx.x == 0) (void)xb_add(&bar[XB_XCNT(b.x)], 1u);
    return b;
}
__device__ __forceinline__ void xcd_barrier_complete(unsigned* bar, unsigned x, unsigned& nloc, unsigned& nx) {
    const unsigned G = gridDim.x * gridDim.y * gridDim.z;
    unsigned sum, cnt, mine, sp = 0u;
    for (;;) {
        sum = 0u; cnt = 0u; mine = 0u;
#pragma unroll 1
        for (unsigned j = 0; j < 16; ++j) { const unsigned c = xb_ld(&bar[XB_XCNT(j)]); sum += c; cnt += (c > 0u) ? 1u : 0u; mine = (j == x) ? c : mine; }
        if (sum == G) break;
        __builtin_amdgcn_s_sleep(1);
        if ((++sp & 255u) == 0u) { if (xb_ld(&bar[XB_TMO])) break; if (sp > XB_SPIN_CAP) { atomicAdd(&bar[XB_TMO], 1u); break; } }
    }
    nloc = mine > 0u ? mine : 1u; nx = cnt > 0u ? cnt : 1u;
}
__device__ __forceinline__ void xcd_barrier(const XcdBarrier& b) {
    asm volatile("s_waitcnt vmcnt(0)" ::: "memory");
    __syncthreads();
    if (threadIdx.x == 0) {
        unsigned* bar = b.bar;
        __builtin_amdgcn_s_waitcnt(0);
        unsigned nloc = b.st[0], nx = b.st[1];
        if (nloc == 0u) { xcd_barrier_complete(bar, b.x, nloc, nx); b.st[0] = nloc; b.st[1] = nx; }
        const unsigned old = xb_add(&bar[XB_XSUB(b.x)], 1u);
        const unsigned gen = old / nloc;
        if (old + 1u == (gen + 1u) * nloc) {
            __builtin_amdgcn_fence(__ATOMIC_RELEASE, "agent");
            asm volatile("s_waitcnt vmcnt(0)" ::: "memory");
            const unsigned og = xb_add(&bar[XB_TOP], 1u);
            const unsigned tg = og / nx;
            if (og + 1u == (tg + 1u) * nx) xb_add(&bar[XB_TOPGEN], 1u);
            else XB_SPIN(xb_ld(&bar[XB_TOPGEN]) == tg, bar);
            __builtin_amdgcn_fence(__ATOMIC_ACQUIRE, "agent");
            xb_add(&bar[XB_XGEN(b.x)], 1u);
            asm volatile("s_waitcnt vmcnt(0)" ::: "memory");
        } else {
            XB_SPIN(xb_ld(&bar[XB_XGEN(b.x)]) == gen, bar);
            __builtin_amdgcn_fence(__ATOMIC_ACQUIRE, "agent");
            asm volatile("s_waitcnt vmcnt(0)" ::: "memory");
        }
    }
    __syncthreads();
}

namespace pg8 {
constexpr int BM = 256, BK = 64, HALF = 128, HTB = HALF * BK * 2, STAGE_BYTES = 8 * HTB;
__host__ __device__ __forceinline__ int lds_byte(int r, int c) { const int st = (r >> 4) * 2 + (c >> 5), rr = r & 15, cc = c & 31, ob = rr * 64 + cc * 2; return st * 1024 + (ob ^ (((ob >> 9) & 1) << 5)); }
__host__ __device__ __forceinline__ void stage_rc(int b, int& R, int& C) { const int st = b / 1024, sb = b % 1024, swz = sb ^ (((sb >> 9) & 1) << 5); R = (st >> 1) * 16 + swz / 64; C = (st & 1) * 32 + (swz % 64) / 2; }
__host__ __device__ __forceinline__ int perm32(int rho) { const int n = rho >> 4, i = rho & 15; return 8 * (i >> 2) + 4 * n + (i & 3); }
__host__ __device__ __forceinline__ int perm32p(int rho) { const int n = rho >> 4, i = rho & 15, q = i >> 2; return 16 * (q & 1) + 2 * (4 * n + (i & 3)) + (q >> 1); }
struct EpiS1;
template <class E> struct PermKind { static constexpr int v = E::PERM ? 1 : 0; };
template <> struct PermKind<EpiS1> { static constexpr int v = 2; };

struct Unit { int pm, pn; const char* pa; const char* pb; long oo; long hb; int nt; };

__device__ __forceinline__ void tile_order(int L, int nM, int nN, int& pm, int& pn) {
    const int nwg = nM * nN; int wgid = L;
    { const int q = nwg / 8, r = nwg % 8, xcd = wgid % 8, off = wgid / 8; wgid = (xcd < r ? xcd * (q + 1) : r * (q + 1) + (xcd - r) * q) + off; }
    const int nig = 8 * nN, gid = wgid / nig, fm = gid * 8, gsz = (nM - fm) < 8 ? (nM - fm) : 8;
    pm = fm + ((wgid % nig) % gsz); pn = (wgid % nig) / gsz;
}

template <class Epi, class Sched, bool ALIGN_EPI>
__device__ __forceinline__ void gemm_phase(LAS unsigned char* lds, const int K, const int lda, const int ldb, const Sched& S, const Epi& E, const int G, const int c) {
    int tid_ = threadIdx.x; asm volatile("" : "+v"(tid_));
    const int tid = tid_, wid = __builtin_amdgcn_readfirstlane(tid >> 6), lane = tid & 63, wr = wid >> 2, wc = wid & 3, fr = lane & 15, fq = lane >> 4;
    const int nt_full = K / BK;
    int voffA[2], voffB[2], voffB1[2];
#pragma unroll
    for (int i = 0; i < 2; ++i) { int R, C; stage_rc(tid * 16 + i * 8192, R, C); const int Rb = PermKind<Epi>::v == 2 ? ((R & ~31) + perm32p(R & 31)) : PermKind<Epi>::v == 1 ? ((R & ~31) + perm32(R & 31)) : R;
        voffA[i] = (Sched::a_row(R) * lda + C) * 2; voffB[i] = (Rb * ldb + C) * 2; voffB1[i] = Sched::B_MIRROR ? (-Rb * ldb + C) * 2 : voffB[i]; }
    const size_t kstep = (size_t)(BK * 2);
    const size_t hstepA = (size_t)Sched::A_HROWS * lda * 2;
    const unsigned ldsw = (unsigned)wid * 1024u;
    const int aoff = lds_byte(wr * 64 + fr, fq * 8), boff = lds_byte(wc * 32 + fr, fq * 8);
#define PG8_SA(b, h) (((b) * 2 + (h)) * HTB)
#define PG8_SB(b, h) ((4 + (b) * 2 + (h)) * HTB)
#define PG8_STAGE(bufoff, gbase, voff) do { _Pragma("unroll") for (int _i = 0; _i < 2; ++_i) \
        __builtin_amdgcn_global_load_lds((const unsigned*)((const char*)(gbase) + (long)(voff)[_i]), (LAS unsigned*)(lds + (bufoff) + ldsw + _i * 8192), 16, 0, 0); } while (0)
#define PG8_LDA(dst, b, h) do { _Pragma("unroll") for (int m = 0; m < 4; ++m) _Pragma("unroll") for (int k = 0; k < 2; ++k) dst[m][k] = *(const LAS bf16x8*)(lds + PG8_SA(b, h) + aoff + m * 2048 + k * 1024); } while (0)
#define PG8_LDB(dst, b, h) do { _Pragma("unroll") for (int n = 0; n < 2; ++n) _Pragma("unroll") for (int k = 0; k < 2; ++k) dst[n][k] = *(const LAS bf16x8*)(lds + PG8_SB(b, h) + boff + n * 2048 + k * 1024); } while (0)
#define PG8_MMA(ai, bj, At, Bt) do { __builtin_amdgcn_s_setprio(1); _Pragma("unroll") for (int m = 0; m < 4; ++m) _Pragma("unroll") for (int n = 0; n < 2; ++n) _Pragma("unroll") for (int k = 0; k < 2; ++k) { \
        if constexpr (Epi::I8) acc[ai][bj][m][n] = __builtin_bit_cast(f32x4, __builtin_amdgcn_mfma_i32_16x16x64_i8(__builtin_bit_cast(i32x4, Bt[n][k]), __builtin_bit_cast(i32x4, At[m][k]), __builtin_bit_cast(i32x4, acc[ai][bj][m][n]), 0, 0, 0)); \
        else acc[ai][bj][m][n] = __builtin_amdgcn_mfma_f32_16x16x32_bf16(Bt[n][k], At[m][k], acc[ai][bj][m][n], 0, 0, 0); } __builtin_amdgcn_s_setprio(0); } while (0)
#define PG8_WAIT_V(n) asm volatile("s_waitcnt vmcnt(" #n ")" ::: "memory")
#define PG8_WAIT_L(n) asm volatile("s_waitcnt lgkmcnt(" #n ")" ::: "memory")
#define PG8_BAR __builtin_amdgcn_s_barrier()
#define PG8_SCHED __builtin_amdgcn_sched_barrier(0)
    Unit cur, nxt; int ui = 0;
    { const long L = S.unit(0, c, G); if (L >= S.total()) return; S.decode((int)L, cur); asm volatile("" : "+s"(cur.pa), "+s"(cur.pb)); }
    f32x4 acc[2][2][4][2];
#pragma unroll
    for (int a = 0; a < 2; ++a)
#pragma unroll
        for (int b = 0; b < 2; ++b)
#pragma unroll
            for (int m = 0; m < 4; ++m)
#pragma unroll
                for (int n = 0; n < 2; ++n) acc[a][b][m][n] = (f32x4){0.f, 0.f, 0.f, 0.f};
    bf16x8 At[4][2], B0[2][2], B1[2][2];
    const char* cA = cur.pa; const char* cB = cur.pb;
    long cHB = cur.hb;
    PG8_STAGE(PG8_SB(0, 0), cB, voffB); PG8_STAGE(PG8_SB(0, 1), cB + cHB, voffB1); PG8_STAGE(PG8_SA(0, 0), cA, voffA); PG8_STAGE(PG8_SA(0, 1), cA + hstepA, voffA);
    if (wr == 1) PG8_BAR;
    PG8_WAIT_V(2); PG8_BAR;
    PG8_STAGE(PG8_SB(1, 0), cB + kstep, voffB); PG8_STAGE(PG8_SA(1, 0), cA + kstep, voffA); PG8_STAGE(PG8_SB(1, 1), cB + cHB + kstep, voffB1);
    PG8_WAIT_V(6); PG8_BAR;
    for (;;) {
        bool has_next; { const long L = S.unit(ui + 1, c, G); has_next = L < S.total(); if (has_next) { S.decode((int)L, nxt); asm volatile("" : "+s"(nxt.pa), "+s"(nxt.pb)); } }
        const char* nA = has_next ? nxt.pa : cA; const char* nB = has_next ? nxt.pb : cB; const long nHB = has_next ? nxt.hb : cHB;
        const int nt = Sched::SPLITK ? cur.nt : nt_full;
#pragma clang loop unroll(disable)
        for (int t = 0; t < nt; t += 2) {
            const bool last = (t == nt - 2);
            const char* a1 = cA + (size_t)(t + 1) * kstep;
            const char* a2 = last ? nA : cA + (size_t)(t + 2) * kstep; const char* b2 = last ? nB : cB + (size_t)(t + 2) * kstep;
            const char* a3 = a2 + kstep; const char* b3 = b2 + kstep; const long hB2 = last ? nHB : cHB;
            if constexpr (Epi::HOOK_TILES > 0) { if (t != 0 && (t % Epi::HOOK_TILES) == 0) E.hook(acc, cur, t / Epi::HOOK_TILES, wr, wc, fr, fq); }
            PG8_LDB(B0, 0, 0); PG8_LDB(B1, 0, 1); PG8_SCHED; PG8_LDA(At, 0, 0); PG8_STAGE(PG8_SA(1, 1), a1 + hstepA, voffA);
            PG8_WAIT_V(8); PG8_WAIT_L(0); PG8_BAR; PG8_MMA(0, 0, At, B0); PG8_MMA(0, 1, At, B1); PG8_BAR; PG8_SCHED;
            PG8_LDA(At, 0, 1); PG8_STAGE(PG8_SB(0, 0), b2, voffB); PG8_STAGE(PG8_SB(0, 1), b2 + hB2, voffB1); PG8_STAGE(PG8_SA(0, 0), a2, voffA);
            PG8_WAIT_V(8); PG8_WAIT_L(0); PG8_BAR; PG8_MMA(1, 0, At, B0); PG8_MMA(1, 1, At, B1); PG8_BAR; PG8_SCHED;
            PG8_LDB(B0, 1, 0); PG8_LDB(B1, 1, 1); PG8_SCHED; PG8_LDA(At, 1, 0); PG8_STAGE(PG8_SA(0, 1), a2 + hstepA, voffA);
            PG8_WAIT_V(8); PG8_WAIT_L(0); PG8_BAR; PG8_MMA(0, 0, At, B0); PG8_MMA(0, 1, At, B1); PG8_BAR; PG8_SCHED;
            PG8_LDA(At, 1, 1); PG8_STAGE(PG8_SB(1, 0), b3, voffB); PG8_STAGE(PG8_SB(1, 1), b3 + hB2, voffB1); PG8_STAGE(PG8_SA(1, 0), a3, voffA);
            PG8_WAIT_V(8); PG8_WAIT_L(0); PG8_BAR; PG8_MMA(1, 0, At, B0); PG8_MMA(1, 1, At, B1); PG8_BAR; PG8_SCHED;
        }
        if constexpr (ALIGN_EPI) { if (wr == 0) PG8_BAR; }
        E(acc, cur, wr, wc, fr, fq);
        if (!has_next) break;
#pragma unroll
        for (int a = 0; a < 2; ++a)
#pragma unroll
            for (int b = 0; b < 2; ++b)
#pragma unroll
                for (int m = 0; m < 4; ++m)
#pragma unroll
                    for (int n = 0; n < 2; ++n) acc[a][b][m][n] = (f32x4){0.f, 0.f, 0.f, 0.f};
        cur = nxt; cA = nA; cB = nB; cHB = nHB; ++ui;
        if constexpr (ALIGN_EPI) { if (wr == 1) PG8_BAR; }
    }
    PG8_WAIT_V(0);
    if constexpr (!ALIGN_EPI) { if (wr == 0) PG8_BAR; }
    PG8_BAR;
#undef PG8_SA
#undef PG8_SB
#undef PG8_STAGE
#undef PG8_LDA
#undef PG8_LDB
#undef PG8_MMA
#undef PG8_WAIT_V
#undef PG8_WAIT_L
#undef PG8_BAR
#undef PG8_SCHED
}

struct SchedRect {
    const char* A; const char* B; int nM, nN; size_t aS, bS; int extra; int t_c0, t_g;
    static __device__ __forceinline__ int a_row(int R) { return R; }
    static constexpr int A_HROWS = 128; static constexpr bool B_MIRROR = false; static constexpr bool SPLITK = false;
    __device__ __forceinline__ int total() const { return nM * nN + extra; }
    __device__ __forceinline__ long unit(int ui, int c, int G) const {
        if (t_g == 0) return (long)ui * G + c;
        const int tot = nM * nN + extra, full = tot / G;
        if (ui < full) return (long)ui * G + c;
        const int cc = c - t_c0; if (cc < 0 || cc >= t_g) return tot;
        return (long)full * G + (long)(ui - full) * t_g + cc;
    }
    __device__ __forceinline__ void decode(int L, Unit& u) const {
        const int nr = nM * nN;
        if (L < nr) tile_order(L, nM, nN, u.pm, u.pn);
        else { const int e = L - nr; u.pm = nM + e / 10; const int q = e % 10; u.pn = q < 2 ? 4 + q : 8 + q; }
        u.pa = A + (size_t)u.pm * aS; u.pb = B + (size_t)u.pn * bS; u.oo = 0; u.hb = (long)(bS >> 1);
    }
};
struct SchedUp {
    const char* A; const char* B; int nM, nN; size_t aS, bS;
    static __device__ __forceinline__ int a_row(int R) { return 126 * (R >> 6) + (R & 63); }
    static constexpr int A_HROWS = 64; static constexpr bool B_MIRROR = false; static constexpr bool SPLITK = false;
    __device__ __forceinline__ int total() const { return nM * nN; }
    __device__ __forceinline__ long unit(int ui, int c, int G) const { return (long)ui * G + c; }
    __device__ __forceinline__ void decode(int L, Unit& u) const { tile_order(L, nM, nN, u.pm, u.pn); u.pa = A + (size_t)u.pm * aS; u.pb = B + (size_t)u.pn * bS; u.oo = 0; u.hb = (long)(bS >> 1); }
};
struct SchedJob {
    const char* A; const char* B; int nZ2, nM, nN, nTot; long hbB;
    size_t az1, az2, am, bz1, bz2, bn;
    long oz1, oz2, om, on;
    static __device__ __forceinline__ int a_row(int R) { return R; }
    static constexpr int A_HROWS = 128; static constexpr bool B_MIRROR = false; static constexpr bool SPLITK = false;
    __device__ __forceinline__ int total() const { return nTot; }
    __device__ __forceinline__ long unit(int ui, int c, int G) const { return (long)ui * G + c; }
    __device__ __forceinline__ void decode(int L, Unit& u) const {
        const int per = nM * nN, z = L / per, rem = L - z * per, z1 = z / nZ2, z2 = z - z1 * nZ2;
        tile_order(rem, nM, nN, u.pm, u.pn);
        u.pa = A + (size_t)z1 * az1 + (size_t)z2 * az2 + (size_t)u.pm * am; u.pb = B + (size_t)z1 * bz1 + (size_t)z2 * bz2 + (size_t)u.pn * bn;
        u.oo = (long)z1 * oz1 + (long)z2 * oz2 + (long)u.pm * om + (long)u.pn * on; u.hb = hbB;
    }
};

struct SchedSplit {
    const char* A; const char* B; size_t aS, bS; int pairs, nctx;
    static __device__ __forceinline__ int a_row(int R) { return R; }
    static constexpr int A_HROWS = 128; static constexpr bool B_MIRROR = false; static constexpr bool SPLITK = true;
    __device__ __forceinline__ int total() const { return 1024 + nctx; }
    __device__ __forceinline__ long unit(int ui, int c, int G) const { return (long)ui * G + c; }
    __device__ __forceinline__ void decode(int L, Unit& u) const {
        if (L < 1024) { tile_order(L, 64, 16, u.pm, u.pn); u.pa = A + (size_t)u.pm * aS; u.pb = B + (size_t)u.pn * bS; u.nt = 2 * pairs; u.oo = 0; }
        else { const int e = L - 1024, tile = e >> 3, p = e & 7; u.pm = 64 + (tile >> 4); u.pn = tile & 15;
            const int q = pairs >> 3, r = pairs & 7;
            const int start = p * q + (p < r ? p : r), len = q + (p < r ? 1 : 0);
            u.pa = A + (size_t)u.pm * aS + (size_t)start * 256; u.pb = B + (size_t)u.pn * bS + (size_t)start * 256; u.nt = 2 * len; u.oo = 1 + p; }
        u.hb = (long)(bS >> 1);
    }
};
struct SchedV {
    const char* A; const char* B; int nM;
    static __device__ __forceinline__ int a_row(int R) { return R; }
    static constexpr int A_HROWS = 128; static constexpr bool B_MIRROR = false; static constexpr bool SPLITK = false;
    __device__ __forceinline__ int total() const { return nM * 43; }
    __device__ __forceinline__ long unit(int ui, int c, int G) const { return (long)ui * G + c; }
    __device__ __forceinline__ void decode(int L, Unit& u) const { tile_order(L, nM, 43, u.pm, u.pn);
        u.pa = A + (size_t)u.pm * 256 * DM * 2; u.pb = B + (size_t)(u.pn * 512 + 128) * DM * 2; u.hb = (long)256 * DM * 2; u.oo = 0; }
};
constexpr int ZK = 8320;
struct SchedS1 {
    const char* A; const char* Ub;
    static __device__ __forceinline__ int a_row(int R) { return R; }
    static constexpr int A_HROWS = 128; static constexpr bool B_MIRROR = true; static constexpr bool SPLITK = false;
    __device__ __forceinline__ int total() const { return 8 * 64; }
    __device__ __forceinline__ long unit(int ui, int c, int G) const { return (long)ui * G + c; }
    __device__ __forceinline__ void decode(int L, Unit& u) const {
        const int z = L >> 6, r = L & 63, part = r >> 5, tile = r & 31, n0 = tile * 128, b = z >> 2, g = z & 3;
        u.pm = part; u.pn = tile;
        u.pa = A + (size_t)part * 256 * 256 * 2;
        u.pb = Ub + ((size_t)(b * SEQ + n0) * ACTW + g * 256) * 2;
        u.hb = (long)(SEQ - 2 * n0) * ACTW * 2;
        u.oo = (long)z * 256 * ZK + (part ? 4096 : 0) + n0 / 2;
    }
};
struct SchedDft {
    const char* A; const char* B;
    static __device__ __forceinline__ int a_row(int R) { return R; }
    static constexpr int A_HROWS = 128; static constexpr bool B_MIRROR = false; static constexpr bool SPLITK = true;
    __device__ __forceinline__ int total() const { return 256; }
    __device__ __forceinline__ long unit(int ui, int c, int G) const { return (long)ui * G + c; }
    __device__ __forceinline__ void decode(int L, Unit& u) const {
        const int xcd = L & 7, i = L >> 3, part = xcd >> 1, z = (xcd & 1) * 4 + (i >> 3), tile = i & 7;
        u.pm = tile; u.pn = part;
        u.pa = A + ((size_t)(1 + 256 * tile) * ZK + part * 2048) * 2;
        u.pb = B + ((size_t)z * 256 * ZK + part * 2048) * 2;
        u.hb = 128L * ZK * 2; u.nt = 32; u.oo = ((long)(part * 8 + z) * 2048 + 256 * tile) * 256;
    }
};
struct EpiF32 {
    static constexpr bool PERM = true; static constexpr int HOOK_TILES = 0; static constexpr bool I8 = false;
    float* O;
    __device__ __forceinline__ void hook(f32x4 (&)[2][2][4][2], const Unit&, int, int, int, int, int) const {}
    __device__ __forceinline__ void operator()(const f32x4 (&acc)[2][2][4][2], const Unit& u, int wr, int wc, int fr, int fq) const {
        float* base = O + u.oo + wc * 32 + 8 * fq;
#pragma unroll
        for (int ai = 0; ai < 2; ++ai)
#pragma unroll
            for (int m = 0; m < 4; ++m) { float* rowp = base + (size_t)(ai * HALF + wr * 64 + m * 16 + fr) * 256;
#pragma unroll
                for (int bj = 0; bj < 2; ++bj) { *(f32x4*)(rowp + bj * HALF) = acc[ai][bj][m][0]; *(f32x4*)(rowp + bj * HALF + 4) = acc[ai][bj][m][1]; } }
    }
};
struct EpiStore {
    static constexpr bool PERM = true; static constexpr int HOOK_TILES = 0; static constexpr bool I8 = false;
    bf16* O; int ldc;
    __device__ __forceinline__ void hook(f32x4 (&)[2][2][4][2], const Unit&, int, int, int, int, int) const {}
    __device__ __forceinline__ void operator()(const f32x4 (&acc)[2][2][4][2], const Unit& u, int wr, int wc, int fr, int fq) const {
        bf16* base = O + u.oo + wc * 32 + 8 * fq;
#pragma unroll
        for (int ai = 0; ai < 2; ++ai)
#pragma unroll
            for (int m = 0; m < 4; ++m) { bf16* rowp = base + (size_t)(ai * HALF + wr * 64 + m * 16 + fr) * ldc;
#pragma unroll
                for (int bj = 0; bj < 2; ++bj) { const f32x4 v0 = acc[ai][bj][m][0], v1 = acc[ai][bj][m][1];
                    u32x4 w; w.x = cvt_pk_bf16(v0[0], v0[1]); w.y = cvt_pk_bf16(v0[2], v0[3]); w.z = cvt_pk_bf16(v1[0], v1[1]); w.w = cvt_pk_bf16(v1[2], v1[3]);
                    *(u32x4*)(rowp + bj * HALF) = w; } }
    }
};

struct EpiS1 {
    static constexpr bool PERM = true; static constexpr int HOOK_TILES = 0; static constexpr bool I8 = false;
    bf16* O;
    __device__ __forceinline__ void hook(f32x4 (&)[2][2][4][2], const Unit&, int, int, int, int, int) const {}
    __device__ __forceinline__ void operator()(const f32x4 (&acc)[2][2][4][2], const Unit& u, int wr, int wc, int fr, int fq) const {
        const float sg = u.pm ? -1.0f : 1.0f;
        const bool self0 = (u.pm == 0) && (wc == 0) && (fq == 0) && (u.pn == 0);
        bf16* base = O + u.oo + wc * 16 + 8 * (fq & 1) + ((fq >> 1) ? 2048 : 0);
#pragma unroll
        for (int ai = 0; ai < 2; ++ai)
#pragma unroll
            for (int m = 0; m < 4; ++m) { f32x4 v0 = acc[ai][0][m][0] + sg * acc[ai][1][m][0]; const f32x4 v1 = acc[ai][0][m][1] + sg * acc[ai][1][m][1];
                if (self0) v0[0] = acc[ai][0][m][0][0];
                u32x4 w; w.x = cvt_pk_bf16(v0[0], v0[1]); w.y = cvt_pk_bf16(v0[2], v0[3]); w.z = cvt_pk_bf16(v1[0], v1[1]); w.w = cvt_pk_bf16(v1[2], v1[3]);
                *(u32x4*)(base + (size_t)(ai * HALF + wr * 64 + m * 16 + fr) * ZK) = w; }
    }
};

struct EpiIn {
    static constexpr bool PERM = true; static constexpr int HOOK_TILES = 0; static constexpr bool I8 = false;
    bf16* ACT; bf16* Gt; const float* rope;
    __device__ __forceinline__ void hook(f32x4 (&)[2][2][4][2], const Unit&, int, int, int, int, int) const {}
    __device__ __forceinline__ void operator()(const f32x4 (&acc)[2][2][4][2], const Unit& u, int wr, int wc, int fr, int fq) const {
        const int pn = u.pn;
        const int colw = wc * 32 + 8 * fq;
        if (pn >= 26) {
            const int gi = (pn - 26) >> 4, gpn = (pn - 26) & 15;
            bf16* base = Gt + ((size_t)((gi * 66 + u.pm) * 16 + gpn) * 16 * 8 + (wr * 4 + wc)) * 512 + (size_t)(fq * 16 + fr) * 8;
#pragma unroll
            for (int ai = 0; ai < 2; ++ai)
#pragma unroll
                for (int m = 0; m < 4; ++m)
#pragma unroll
                    for (int bj = 0; bj < 2; ++bj) { const f32x4 v0 = acc[ai][bj][m][0], v1 = acc[ai][bj][m][1];
                        u32x4 w; w.x = cvt_pk_bf16(sigmoidf_(v0[0]), sigmoidf_(v0[1])); w.y = cvt_pk_bf16(sigmoidf_(v0[2]), sigmoidf_(v0[3]));
                        w.z = cvt_pk_bf16(sigmoidf_(v1[0]), sigmoidf_(v1[1])); w.w = cvt_pk_bf16(sigmoidf_(v1[2]), sigmoidf_(v1[3]));
                        *(u32x4*)(base + (size_t)((ai * 4 + m) * 2 + bj) * 4096) = w; }
            return;
        }
        const bool do_rope = pn <= 4;
        const float qs = (pn < 4 || (pn >= 6 && pn < 10)) ? QSCALE : 1.0f;
        bf16* base = ACT + (size_t)pn * 256 + colw;
        const int hf = wc >> 1, i0 = 16 * (wc & 1) + 4 * fq;
        f32x4 csa[8], csb[8];
#pragma unroll
        for (int k = 0; k < 8; ++k) { csa[k] = (f32x4){1.f, 0.f, 1.f, 0.f}; csb[k] = csa[k]; const int row = u.pm * BM + (k >> 2) * HALF + wr * 64 + (k & 3) * 16 + fr;
            if (do_rope && row < TL) { const int t = row & (SEQ - 1), pos = hf ? (t & 63) : (t >> 6); const f32x4* rp = (const f32x4*)(rope + (size_t)(pos * 32 + i0) * 2); csa[k] = rp[0]; csb[k] = rp[1]; } }
#pragma unroll
        for (int ai = 0; ai < 2; ++ai)
#pragma unroll
            for (int m = 0; m < 4; ++m) { const int row = u.pm * BM + ai * HALF + wr * 64 + m * 16 + fr; bf16* rowp = base + (size_t)row * ACTW;
                const f32x4 cs0 = csa[ai * 4 + m], cs1 = csb[ai * 4 + m];
#pragma unroll
                for (int bj = 0; bj < 2; ++bj) { f32x4 v0 = acc[ai][bj][m][0] * qs, v1 = acc[ai][bj][m][1] * qs;
                    if (do_rope) { f32x4 y0, y1;
                        y0[0] = v0[0] * cs0[0] - v0[1] * cs0[1]; y0[1] = v0[0] * cs0[1] + v0[1] * cs0[0]; y0[2] = v0[2] * cs0[2] - v0[3] * cs0[3]; y0[3] = v0[2] * cs0[3] + v0[3] * cs0[2];
                        y1[0] = v1[0] * cs1[0] - v1[1] * cs1[1]; y1[1] = v1[0] * cs1[1] + v1[1] * cs1[0]; y1[2] = v1[2] * cs1[2] - v1[3] * cs1[3]; y1[3] = v1[2] * cs1[3] + v1[3] * cs1[2];
                        v0 = y0; v1 = y1; }
                    u32x4 w; w.x = cvt_pk_bf16(v0[0], v0[1]); w.y = cvt_pk_bf16(v0[2], v0[3]); w.z = cvt_pk_bf16(v1[0], v1[1]); w.w = cvt_pk_bf16(v1[2], v1[3]);
                    *(u32x4*)(rowp + bj * HALF) = w; } }
    }
};

struct EpiGate {
    static constexpr bool PERM = true; static constexpr int HOOK_TILES = 0; static constexpr bool I8 = true;
    bf16* Gt; const float* SH; const float* SW;
    __device__ __forceinline__ void hook(f32x4 (&)[2][2][4][2], const Unit&, int, int, int, int, int) const {}
    __device__ __forceinline__ void operator()(const f32x4 (&acc)[2][2][4][2], const Unit& u, int wr, int wc, int fr, int fq) const {
        const int gi = u.pn >> 4, gpn = u.pn & 15;
        float shr[8]; f32x4 swc[2][2];
#pragma unroll
        for (int k = 0; k < 8; ++k) shr[k] = SH[u.pm * BM + (k >> 2) * HALF + wr * 64 + (k & 3) * 16 + fr];
#pragma unroll
        for (int bj = 0; bj < 2; ++bj)
#pragma unroll
            for (int n = 0; n < 2; ++n) swc[bj][n] = *(const f32x4*)(SW + u.pn * BM + bj * HALF + wc * 32 + 8 * fq + 4 * n) * (-LOG2E);
        bf16* base = Gt + ((size_t)((gi * 66 + u.pm) * 16 + gpn) * 16 * 8 + (wr * 4 + wc)) * 512 + (size_t)(fq * 16 + fr) * 8;
#pragma unroll
        for (int ai = 0; ai < 2; ++ai)
#pragma unroll
            for (int m = 0; m < 4; ++m)
#pragma unroll
                for (int bj = 0; bj < 2; ++bj) { const i32x4 a0 = __builtin_bit_cast(i32x4, acc[ai][bj][m][0]), a1 = __builtin_bit_cast(i32x4, acc[ai][bj][m][1]); const float rs = shr[ai * 4 + m];
                    f32x4 v0, v1;
#pragma unroll
                    for (int j = 0; j < 4; ++j) { v0[j] = (float)a0[j] * rs * swc[bj][0][j]; v1[j] = (float)a1[j] * rs * swc[bj][1][j]; }
#define SG2(x) fast_rcp(1.0f + fast_exp2(x))
                    u32x4 w; w.x = cvt_pk_bf16(SG2(v0[0]), SG2(v0[1])); w.y = cvt_pk_bf16(SG2(v0[2]), SG2(v0[3]));
                    w.z = cvt_pk_bf16(SG2(v1[0]), SG2(v1[1])); w.w = cvt_pk_bf16(SG2(v1[2]), SG2(v1[3]));
#undef SG2
                    *(u32x4*)(base + (size_t)((ai * 4 + m) * 2 + bj) * 4096) = w; }
    }
};

struct EpiMerge {
    static constexpr bool PERM = true; static constexpr int HOOK_TILES = 16; static constexpr bool I8 = false;
    const bf16* Gt; bf16* MG; float* slab;
    static __device__ __forceinline__ float clampg(float s) { return fmaxf(s, 1e-9f); }
    __device__ __forceinline__ void hook(f32x4 (&acc)[2][2][4][2], const Unit& u, int j1, int wr, int wc, int fr, int fq) const {
        asm volatile("" : "+v"(fr), "+v"(fq));
        const bf16* g0 = Gt + ((size_t)(((j1 - 1) * 66 + u.pm) * 16 + u.pn) * 16 * 8 + (wr * 4 + wc)) * 512 + (size_t)(fq * 16 + fr) * 8;
        const bf16* g1 = g0 + (size_t)66 * 16 * 16 * 8 * 512;
#pragma unroll
        for (int ai = 0; ai < 2; ++ai) {
            u32x4 ga[4][2], gb[4][2];
#pragma unroll
            for (int m = 0; m < 4; ++m)
#pragma unroll
                for (int bj = 0; bj < 2; ++bj) { const size_t go = (size_t)((ai * 4 + m) * 2 + bj) * 4096; ga[m][bj] = *(const u32x4*)(g0 + go); gb[m][bj] = *(const u32x4*)(g1 + go); }
            asm volatile("s_waitcnt vmcnt(0)" ::: "memory");
#pragma unroll
            for (int m = 0; m < 4; ++m)
#pragma unroll
                for (int bj = 0; bj < 2; ++bj) { const u32x4 a = ga[m][bj], b = gb[m][bj];
                    f32x4 r0, r1;
                    r0[0] = clampg(bflo(a.x)) * fast_rcp(clampg(bflo(b.x))); r0[1] = clampg(bfhi(a.x)) * fast_rcp(clampg(bfhi(b.x)));
                    r0[2] = clampg(bflo(a.y)) * fast_rcp(clampg(bflo(b.y))); r0[3] = clampg(bfhi(a.y)) * fast_rcp(clampg(bfhi(b.y)));
                    r1[0] = clampg(bflo(a.z)) * fast_rcp(clampg(bflo(b.z))); r1[1] = clampg(bfhi(a.z)) * fast_rcp(clampg(bfhi(b.z)));
                    r1[2] = clampg(bflo(a.w)) * fast_rcp(clampg(bflo(b.w))); r1[3] = clampg(bfhi(a.w)) * fast_rcp(clampg(bfhi(b.w)));
                    acc[ai][bj][m][0] *= r0; acc[ai][bj][m][1] *= r1; }
            asm volatile("" ::: "memory");
        }
    }
    __device__ __forceinline__ void operator()(const f32x4 (&acc)[2][2][4][2], const Unit& u, int wr, int wc, int fr, int fq) const {
        const size_t cofs = (size_t)u.pn * 256 + wc * 32 + 8 * fq;
        if (u.oo >= 1) {
            const int p = (int)u.oo - 1;
            const bf16* gi = Gt + ((size_t)(((p >> 1) * 66 + u.pm) * 16 + u.pn) * 16 * 8 + (wr * 4 + wc)) * 512 + (size_t)(fq * 16 + fr) * 8;
            float* sl = slab + (size_t)p * TC * DM + cofs;
#pragma unroll
            for (int ai = 0; ai < 2; ++ai) {
                u32x4 ga[4][2];
#pragma unroll
                for (int m = 0; m < 4; ++m)
#pragma unroll
                    for (int bj = 0; bj < 2; ++bj) ga[m][bj] = *(const u32x4*)(gi + (size_t)((ai * 4 + m) * 2 + bj) * 4096);
#pragma unroll
                for (int m = 0; m < 4; ++m) { const size_t row = (size_t)(u.pm * BM + ai * HALF + wr * 64 + m * 16 + fr - TL);
#pragma unroll
                    for (int bj = 0; bj < 2; ++bj) { const u32x4 a = ga[m][bj]; const f32x4 v0 = acc[ai][bj][m][0], v1 = acc[ai][bj][m][1];
                        const f32x4 o0 = {v0[0] * clampg(bflo(a.x)), v0[1] * clampg(bfhi(a.x)), v0[2] * clampg(bflo(a.y)), v0[3] * clampg(bfhi(a.y))};
                        const f32x4 o1 = {v1[0] * clampg(bflo(a.z)), v1[1] * clampg(bfhi(a.z)), v1[2] * clampg(bflo(a.w)), v1[3] * clampg(bfhi(a.w))};
                        *(f32x4*)(sl + row * DM + bj * HALF) = o0; *(f32x4*)(sl + row * DM + bj * HALF + 4) = o1; } } }
            return;
        }
        const bf16* g3 = Gt + ((size_t)((3 * 66 + u.pm) * 16 + u.pn) * 16 * 8 + (wr * 4 + wc)) * 512 + (size_t)(fq * 16 + fr) * 8;
#pragma unroll
        for (int ai = 0; ai < 2; ++ai) {
            u32x4 ga[4][2];
#pragma unroll
            for (int m = 0; m < 4; ++m)
#pragma unroll
                for (int bj = 0; bj < 2; ++bj) ga[m][bj] = *(const u32x4*)(g3 + (size_t)((ai * 4 + m) * 2 + bj) * 4096);
#pragma unroll
            for (int m = 0; m < 4; ++m) { const size_t row = (size_t)(u.pm * BM + ai * HALF + wr * 64 + m * 16 + fr);
#pragma unroll
                for (int bj = 0; bj < 2; ++bj) { const u32x4 a = ga[m][bj]; const f32x4 v0 = acc[ai][bj][m][0], v1 = acc[ai][bj][m][1];
                    u32x4 w; w.x = cvt_pk_bf16(v0[0] * clampg(bflo(a.x)), v0[1] * clampg(bfhi(a.x))); w.y = cvt_pk_bf16(v0[2] * clampg(bflo(a.y)), v0[3] * clampg(bfhi(a.y)));
                    w.z = cvt_pk_bf16(v1[0] * clampg(bflo(a.z)), v1[1] * clampg(bfhi(a.z))); w.w = cvt_pk_bf16(v1[2] * clampg(bflo(a.w)), v1[3] * clampg(bfhi(a.w)));
                    *(u32x4*)(MG + row * DM + cofs + bj * HALF) = w; } }
            asm volatile("" ::: "memory");
        }
    }
};

struct EpiResid {
    static constexpr bool PERM = false; static constexpr int HOOK_TILES = 0; static constexpr bool I8 = false;
    const float* r_lat; const float* r_ctx; float* X; const float* gt; float* slab;
    __device__ __forceinline__ void hook(f32x4 (&)[2][2][4][2], const Unit&, int, int, int, int, int) const {}
    __device__ __forceinline__ void operator()(const f32x4 (&acc)[2][2][4][2], const Unit& u, int wr, int wc, int fr, int fq) const {
        const int var = u.pm < 32 ? 0 : (u.pm < 64 ? 1 : 2);
        const int col0 = u.pn * BM + wc * 32 + 4 * fq;
        const float* gv = gt + (size_t)var * MODW + col0;
        f32x4 gg[2][2];
#pragma unroll
        for (int bj = 0; bj < 2; ++bj)
#pragma unroll
            for (int n = 0; n < 2; ++n) gg[bj][n] = *(const f32x4*)(gv + bj * HALF + n * 16);
        if (u.oo >= 1) {
            float* sl = slab + (size_t)(u.oo - 1) * TC * DM;
#pragma unroll
            for (int ai = 0; ai < 2; ++ai)
#pragma unroll
                for (int m = 0; m < 4; ++m) { const int row = u.pm * BM + ai * HALF + wr * 64 + m * 16 + fr - TL; float* xp = sl + (size_t)row * DM + col0;
#pragma unroll
                    for (int bj = 0; bj < 2; ++bj)
#pragma unroll
                        for (int n = 0; n < 2; ++n) *(f32x4*)(xp + bj * HALF + n * 16) = gg[bj][n] * acc[ai][bj][m][n]; }
            return;
        }
#pragma unroll
        for (int ai = 0; ai < 2; ++ai) {
            f32x4 rr[4][2][2];
#pragma unroll
            for (int m = 0; m < 4; ++m) { const int row = u.pm * BM + ai * HALF + wr * 64 + m * 16 + fr;
                const float* rp = (row < TL ? r_lat + (size_t)row * DM : r_ctx + (size_t)(row - TL) * DM) + col0;
#pragma unroll
                for (int bj = 0; bj < 2; ++bj)
#pragma unroll
                    for (int n = 0; n < 2; ++n) rr[m][bj][n] = *(const f32x4*)(rp + bj * HALF + n * 16); }
#pragma unroll
            for (int m = 0; m < 4; ++m) { const int row = u.pm * BM + ai * HALF + wr * 64 + m * 16 + fr; float* xp = X + (size_t)row * DM + col0;
#pragma unroll
                for (int bj = 0; bj < 2; ++bj)
#pragma unroll
                    for (int n = 0; n < 2; ++n) *(f32x4*)(xp + bj * HALF + n * 16) = rr[m][bj][n] + gg[bj][n] * acc[ai][bj][m][n]; }
            asm volatile("" ::: "memory");
        }
    }
};

__device__ __forceinline__ float dpp_ror1(float x) { return __builtin_bit_cast(float, __builtin_amdgcn_update_dpp(0, __builtin_bit_cast(int, x), 0x121, 0xF, 0xF, false)); }
__device__ __forceinline__ float dpp_ror15(float x) { return __builtin_bit_cast(float, __builtin_amdgcn_update_dpp(0, __builtin_bit_cast(int, x), 0x12F, 0xF, 0xF, false)); }
struct EpiA8 {
    static constexpr bool PERM = true; static constexpr int HOOK_TILES = 0; static constexpr bool I8 = true;
    bf16* U; const float* cw; const float* cb; const float* SH; const float* SW;
    __device__ __forceinline__ void hook(f32x4 (&)[2][2][4][2], const Unit&, int, int, int, int, int) const {}
    __device__ __forceinline__ void operator()(const f32x4 (&acc)[2][2][4][2], const Unit& u, int wr, int wc, int fr, int fq) const {
        const int Rbase = 252 * u.pm - 1 + 126 * wr;
        float shr[8];
#pragma unroll
        for (int k = 0; k < 8; ++k) { const int R = Rbase + 16 * k + fr; shr[k] = SH[min(max(R, 0), T - 1)]; }
        int lfr = fr;
#pragma unroll
        for (int bj = 0; bj < 2; ++bj) {
            asm volatile("" : "+v"(lfr));
            const int ch0 = u.pn * 256 + bj * 128 + wc * 32 + 8 * fq;
            float w0[8], w1[8], w2[8], bb[8], sw[8];
            { const f32x4 a0 = *(const f32x4*)(cw + ch0), a1 = *(const f32x4*)(cw + ch0 + 4), b0 = *(const f32x4*)(cw + DFF + ch0), b1 = *(const f32x4*)(cw + DFF + ch0 + 4);
              const f32x4 c0 = *(const f32x4*)(cw + 2 * DFF + ch0), c1 = *(const f32x4*)(cw + 2 * DFF + ch0 + 4), d0 = *(const f32x4*)(cb + ch0), d1 = *(const f32x4*)(cb + ch0 + 4);
              const f32x4 e0 = *(const f32x4*)(SW + ch0), e1 = *(const f32x4*)(SW + ch0 + 4);
#pragma unroll
              for (int q = 0; q < 4; ++q) { w0[q] = a0[q]; w0[4 + q] = a1[q]; w1[q] = b0[q]; w1[4 + q] = b1[q]; w2[q] = c0[q]; w2[4 + q] = c1[q]; bb[q] = d0[q]; bb[4 + q] = d1[q]; sw[q] = e0[q]; sw[4 + q] = e1[q]; } }
#define A8G(k, cc) ((float)__builtin_bit_cast(i32x4, acc[(k) >> 2][bj][(k) & 3][(cc) >> 2])[(cc) & 3] * shr[k] * sw[cc])
            float spp[8], spc[8], snc[8], snn[8], gcur[8], gnx[8];
#pragma unroll
            for (int cc = 0; cc < 8; ++cc) { spp[cc] = 0.f; gcur[cc] = A8G(0, cc); spc[cc] = dpp_ror1(gcur[cc]); snc[cc] = dpp_ror15(gcur[cc]); }
#pragma unroll
            for (int k = 0; k < 8; ++k) {
                asm volatile("" : "+v"(lfr));
                if (k < 7) {
#pragma unroll
                    for (int cc = 0; cc < 8; ++cc) { gnx[cc] = A8G(k + 1, cc); snn[cc] = dpp_ror15(gnx[cc]); }
                } else {
#pragma unroll
                    for (int cc = 0; cc < 8; ++cc) { gnx[cc] = 0.f; snn[cc] = 0.f; }
                }
                const int y = 16 * k + lfr, R = Rbase + y;
                const bool fst = (R < TL) ? ((R & (SEQ - 1)) == 0) : ((R & 255) == 0), lst = (R < TL) ? ((R & (SEQ - 1)) == SEQ - 1) : ((R & 255) == 255);
                float res[8];
#pragma unroll
                for (int cc = 0; cc < 8; ++cc) {
                    float P = (lfr > 0) ? spc[cc] : spp[cc], N = (lfr < 15) ? snc[cc] : snn[cc];
                    P = fst ? 0.f : P; N = lst ? 0.f : N;
                    const float a = w0[cc] * P + w1[cc] * gcur[cc] + w2[cc] * N + bb[cc];
                    res[cc] = a * sigmoidf_(a);
                }
                if (y >= 1 && y <= 126 && R < T) { u32x4 w; w.x = cvt_pk_bf16(res[0], res[1]); w.y = cvt_pk_bf16(res[2], res[3]); w.z = cvt_pk_bf16(res[4], res[5]); w.w = cvt_pk_bf16(res[6], res[7]);
                    *(u32x4*)(U + (size_t)R * DFF + ch0) = w; }
                if (k < 7) {
#pragma unroll
                    for (int cc = 0; cc < 8; ++cc) { spp[cc] = spc[cc]; gcur[cc] = gnx[cc]; spc[cc] = dpp_ror1(gnx[cc]); snc[cc] = snn[cc]; }
                }
            }
#undef A8G
        }
    }
};
struct EpiUp8 {
    static constexpr bool PERM = true; static constexpr int HOOK_TILES = 0; static constexpr bool I8 = true;
    bf16* U; const float* cw; const float* cb; const float* SH; const float* SW;
    __device__ __forceinline__ void hook(f32x4 (&)[2][2][4][2], const Unit&, int, int, int, int, int) const {}
    __device__ __forceinline__ void operator()(const f32x4 (&acc)[2][2][4][2], const Unit& u, int wr, int wc, int fr, int fq) const {
        const int Rbase = 252 * u.pm - 1 + 126 * wr;
        const int ch0 = u.pn * 128 + wc * 32 + 8 * fq;
        float shr[8];
#pragma unroll
        for (int k = 0; k < 8; ++k) { const int R = Rbase + 16 * k + fr; shr[k] = SH[min(max(R, 0), T - 1)]; }
        float w0[8], w1[8], w2[8], bb[8], swg[8], swv[8];
        { const f32x4 a0 = *(const f32x4*)(cw + ch0), a1 = *(const f32x4*)(cw + ch0 + 4), b0 = *(const f32x4*)(cw + DFF + ch0), b1 = *(const f32x4*)(cw + DFF + ch0 + 4);
          const f32x4 c0 = *(const f32x4*)(cw + 2 * DFF + ch0), c1 = *(const f32x4*)(cw + 2 * DFF + ch0 + 4), d0 = *(const f32x4*)(cb + ch0), d1 = *(const f32x4*)(cb + ch0 + 4);
          const float* sp = SW + u.pn * 256 + wc * 32 + 8 * fq;
          const f32x4 e0 = *(const f32x4*)sp, e1 = *(const f32x4*)(sp + 4), f0 = *(const f32x4*)(sp + 128), f1 = *(const f32x4*)(sp + 132);
#pragma unroll
          for (int q = 0; q < 4; ++q) { w0[q] = a0[q]; w0[4 + q] = a1[q]; w1[q] = b0[q]; w1[4 + q] = b1[q]; w2[q] = c0[q]; w2[4 + q] = c1[q]; bb[q] = d0[q]; bb[4 + q] = d1[q];
              swg[q] = e0[q]; swg[4 + q] = e1[q]; swv[q] = f0[q]; swv[4 + q] = f1[q]; } }
#define U8G(k, cc) ((float)__builtin_bit_cast(i32x4, acc[(k) >> 2][0][(k) & 3][(cc) >> 2])[(cc) & 3] * shr[k])
#define U8V(k, cc) ((float)__builtin_bit_cast(i32x4, acc[(k) >> 2][1][(k) & 3][(cc) >> 2])[(cc) & 3] * shr[k] * swv[cc])
#pragma unroll
        for (int cc = 0; cc < 8; ++cc) { w0[cc] *= swg[cc]; w1[cc] *= swg[cc]; w2[cc] *= swg[cc]; }
        int lfr = fr;
        float spp[8], spc[8], snc[8], snn[8], gcur[8], gnx[8];
#pragma unroll
        for (int cc = 0; cc < 8; ++cc) { spp[cc] = 0.f; gcur[cc] = U8G(0, cc); spc[cc] = dpp_ror1(gcur[cc]); snc[cc] = dpp_ror15(gcur[cc]); }
#pragma unroll
        for (int k = 0; k < 8; ++k) {
            asm volatile("" : "+v"(lfr));
            if (k < 7) {
#pragma unroll
                for (int cc = 0; cc < 8; ++cc) { gnx[cc] = U8G(k + 1, cc); snn[cc] = dpp_ror15(gnx[cc]); }
            } else {
#pragma unroll
                for (int cc = 0; cc < 8; ++cc) { gnx[cc] = 0.f; snn[cc] = 0.f; }
            }
            const int y = 16 * k + lfr, R = Rbase + y;
            const bool fst = (R < TL) ? ((R & (SEQ - 1)) == 0) : ((R & 255) == 0), lst = (R < TL) ? ((R & (SEQ - 1)) == SEQ - 1) : ((R & 255) == 255);
            float res[8];
#pragma unroll
            for (int cc = 0; cc < 8; ++cc) {
                float P = (lfr > 0) ? spc[cc] : spp[cc], N = (lfr < 15) ? snc[cc] : snn[cc];
                P = fst ? 0.f : P; N = lst ? 0.f : N;
                const float a = w0[cc] * P + w1[cc] * gcur[cc] + w2[cc] * N + bb[cc];
                res[cc] = a * sigmoidf_(a) * U8V(k, cc);
            }
            if (y >= 1 && y <= 126 && R < T) { u32x4 w; w.x = cvt_pk_bf16(res[0], res[1]); w.y = cvt_pk_bf16(res[2], res[3]); w.z = cvt_pk_bf16(res[4], res[5]); w.w = cvt_pk_bf16(res[6], res[7]);
                *(u32x4*)(U + (size_t)R * DFF + ch0) = w; }
            if (k < 7) {
#pragma unroll
                for (int cc = 0; cc < 8; ++cc) { spp[cc] = spc[cc]; gcur[cc] = gnx[cc]; spc[cc] = dpp_ror1(gnx[cc]); snc[cc] = snn[cc]; }
            }
        }
#undef U8G
#undef U8V
    }
};
struct EpiV8 {
    static constexpr bool PERM = true; static constexpr int HOOK_TILES = 0; static constexpr bool I8 = true;
    bf16* U; const float* SH; const float* SW;
    __device__ __forceinline__ void hook(f32x4 (&)[2][2][4][2], const Unit&, int, int, int, int, int) const {}
    __device__ __forceinline__ void operator()(const f32x4 (&acc)[2][2][4][2], const Unit& u, int wr, int wc, int fr, int fq) const {
        bf16* base = U + (size_t)u.pn * 256 + wc * 32 + 8 * fq;
        float shr[8]; f32x4 swc[2][2];
#pragma unroll
        for (int k = 0; k < 8; ++k) shr[k] = SH[u.pm * BM + (k >> 2) * HALF + wr * 64 + (k & 3) * 16 + fr];
#pragma unroll
        for (int bj = 0; bj < 2; ++bj)
#pragma unroll
            for (int n = 0; n < 2; ++n) swc[bj][n] = *(const f32x4*)(SW + u.pn * BM + bj * HALF + wc * 32 + 8 * fq + 4 * n);
#pragma unroll
        for (int ai = 0; ai < 2; ++ai) {
            u32x4 gg[4][2];
#pragma unroll
            for (int m = 0; m < 4; ++m)
#pragma unroll
                for (int bj = 0; bj < 2; ++bj) gg[m][bj] = *(const u32x4*)(base + (size_t)(u.pm * BM + ai * HALF + wr * 64 + m * 16 + fr) * DFF + bj * HALF);
#pragma unroll
            for (int m = 0; m < 4; ++m)
#pragma unroll
                for (int bj = 0; bj < 2; ++bj) { const u32x4 a = gg[m][bj]; const i32x4 a0 = __builtin_bit_cast(i32x4, acc[ai][bj][m][0]), a1 = __builtin_bit_cast(i32x4, acc[ai][bj][m][1]); const float rs = shr[ai * 4 + m];
                    f32x4 v0, v1;
#pragma unroll
                    for (int j = 0; j < 4; ++j) { v0[j] = (float)a0[j] * rs * swc[bj][0][j]; v1[j] = (float)a1[j] * rs * swc[bj][1][j]; }
                    u32x4 w; w.x = cvt_pk_bf16(v0[0] * bflo(a.x), v0[1] * bfhi(a.x)); w.y = cvt_pk_bf16(v0[2] * bflo(a.y), v0[3] * bfhi(a.y));
                    w.z = cvt_pk_bf16(v1[0] * bflo(a.z), v1[1] * bfhi(a.z)); w.w = cvt_pk_bf16(v1[2] * bflo(a.w), v1[3] * bfhi(a.w));
                    *(u32x4*)(base + (size_t)(u.pm * BM + ai * HALF + wr * 64 + m * 16 + fr) * DFF + bj * HALF) = w; }
            asm volatile("" ::: "memory");
        }
    }
};
struct EpiV {
    static constexpr bool PERM = true; static constexpr int HOOK_TILES = 0; static constexpr bool I8 = false;
    bf16* U;
    __device__ __forceinline__ void hook(f32x4 (&)[2][2][4][2], const Unit&, int, int, int, int, int) const {}
    __device__ __forceinline__ void operator()(const f32x4 (&acc)[2][2][4][2], const Unit& u, int wr, int wc, int fr, int fq) const {
        bf16* base = U + (size_t)u.pn * 256 + wc * 32 + 8 * fq;
#pragma unroll
        for (int ai = 0; ai < 2; ++ai) {
            u32x4 gg[4][2];
#pragma unroll
            for (int m = 0; m < 4; ++m)
#pragma unroll
                for (int bj = 0; bj < 2; ++bj) gg[m][bj] = *(const u32x4*)(base + (size_t)(u.pm * BM + ai * HALF + wr * 64 + m * 16 + fr) * DFF + bj * HALF);
#pragma unroll
            for (int m = 0; m < 4; ++m)
#pragma unroll
                for (int bj = 0; bj < 2; ++bj) { const u32x4 a = gg[m][bj]; const f32x4 v0 = acc[ai][bj][m][0], v1 = acc[ai][bj][m][1];
                    u32x4 w; w.x = cvt_pk_bf16(v0[0] * bflo(a.x), v0[1] * bfhi(a.x)); w.y = cvt_pk_bf16(v0[2] * bflo(a.y), v0[3] * bfhi(a.y));
                    w.z = cvt_pk_bf16(v1[0] * bflo(a.z), v1[1] * bfhi(a.z)); w.w = cvt_pk_bf16(v1[2] * bflo(a.w), v1[3] * bfhi(a.w));
                    *(u32x4*)(base + (size_t)(u.pm * BM + ai * HALF + wr * 64 + m * 16 + fr) * DFF + bj * HALF) = w; }
            asm volatile("" ::: "memory");
        }
    }
};
}

namespace att {
constexpr int SHM_V = 16384, SHM_K = 16384;
constexpr int OFF_V = 0, OFF_K = 2 * SHM_V, OFF_WS = 2 * SHM_V + 2 * SHM_K, OFF_TAB = OFF_WS + NWAVES * 256;
constexpr float THR = 11.5f;
#define KSWZ(row, colB) ((row) * 256 + ((colB) ^ (((row) & 7) << 4)))
#define SBAR() __builtin_amdgcn_sched_barrier(0)
__device__ __forceinline__ int crow(int r, int hi) { return (r & 3) + 8 * (r >> 2) + 4 * hi; }
__device__ __forceinline__ int v_st(int k, int c) { const int kk = (k & ~0xC) | ((k & 4) << 1) | ((k & 8) >> 1); return ((kk >> 3) * 4 + (c >> 5)) * 512 + ((kk & 7) * 32 + (c & 31)) * 2; }
__device__ __forceinline__ int v_rd_base(int lane) { return ((lane & 3) << 3) | (((lane >> 2) & 3) << 6) | (((lane >> 4) & 1) << 5) | (((lane >> 5) & 1) << 8); }
constexpr int v_rd_off(int d0, int ks, int half) { return d0 * 512 + ks * 4096 + half * 2048; }
template <int OFF> __device__ __forceinline__ s16x4 tr_read(int vb) { s16x4 r; asm volatile("ds_read_b64_tr_b16 %0, %1 offset:%2" : "=&v"(r) : "v"(vb), "i"(OFF) : "memory"); return r; }
template <int D0> __device__ __forceinline__ void pv_one(f32x16& od, int vb, bf16x8 pa0, bf16x8 pa1, bf16x8 pa2, bf16x8 pa3) {
    const s16x4 l0 = tr_read<v_rd_off(D0, 0, 0)>(vb), h0 = tr_read<v_rd_off(D0, 0, 1)>(vb), l1 = tr_read<v_rd_off(D0, 1, 0)>(vb), h1 = tr_read<v_rd_off(D0, 1, 1)>(vb);
    const s16x4 l2 = tr_read<v_rd_off(D0, 2, 0)>(vb), h2 = tr_read<v_rd_off(D0, 2, 1)>(vb), l3 = tr_read<v_rd_off(D0, 3, 0)>(vb), h3 = tr_read<v_rd_off(D0, 3, 1)>(vb);
    asm volatile("s_waitcnt lgkmcnt(0)" ::: "memory"); SBAR();
#define PK(L, H) (bf16x8){L[0], L[1], L[2], L[3], H[0], H[1], H[2], H[3]}
    od = __builtin_amdgcn_mfma_f32_32x32x16_bf16(pa0, PK(l0, h0), od, 0, 0, 0);
    od = __builtin_amdgcn_mfma_f32_32x32x16_bf16(pa1, PK(l1, h1), od, 0, 0, 0);
    od = __builtin_amdgcn_mfma_f32_32x32x16_bf16(pa2, PK(l2, h2), od, 0, 0, 0);
    od = __builtin_amdgcn_mfma_f32_32x32x16_bf16(pa3, PK(l3, h3), od, 0, 0, 0);
#undef PK
}
__device__ __forceinline__ void qkt(f32x16& p0, f32x16& p1, const LAS char* Ks, const bf16x8 (&qr)[8], int r32, int hi) {
    p0 = f32x16{}; p1 = f32x16{};
#pragma unroll
    for (int d0 = 0; d0 < 8; ++d0) { const int cb = (d0 * 16 + hi * 8) * 2;
        const bf16x8 b0 = *(const LAS bf16x8*)(Ks + KSWZ(r32, cb));
        const bf16x8 b1 = *(const LAS bf16x8*)(Ks + KSWZ(32 + r32, cb));
        p0 = __builtin_amdgcn_mfma_f32_32x32x16_bf16(b0, qr[d0], p0, 0, 0, 0);
        p1 = __builtin_amdgcn_mfma_f32_32x32x16_bf16(b1, qr[d0], p1, 0, 0, 0); }
}

__device__ __forceinline__ void attn_unit(LAS char* lds, const bf16* __restrict__ ACT, bf16* __restrict__ YC, const float* __restrict__ sink, const float* __restrict__ rpb,
                                          int kind, int b, int hh, int blk) {
    int tid_ = threadIdx.x; asm volatile("" : "+v"(tid_));
    const int tid = tid_, wid = __builtin_amdgcn_readfirstlane(tid >> 6), lane = tid & 63, r32 = lane & 31, hi = lane >> 5;
    LAS char* V_lds = lds + OFF_V; LAS char* K_lds = lds + OFF_K;
    LAS float* wsf = (LAS float*)(lds + OFF_WS) + wid * 64; LAS float* li_l = wsf; LAS float* al_l = wsf + 32;
    LAS float* tab = (LAS float*)(lds + OFF_TAB);
    const bool isA = (kind == 0 || kind == 2);
    int head, qrow0;
    if (kind == 0)      { head = hh * 4 + (wid >> 1); qrow0 = b * SEQ + blk * 64 + (wid & 1) * 32; }
    else if (kind == 1) { head = hh;                  qrow0 = b * SEQ + blk * 256 + wid * 32; }
    else if (kind == 2) { head = hh * 4 + (wid >> 1); qrow0 = TL + b * CTXL + blk * 64 + (wid & 1) * 32; }
    else                { head = hh;                  qrow0 = TL + b * CTXL + wid * 32; }
    const int qcolofs = isA ? OFF_AQ + head * 128 : OFF_NQ + head * 128;
    const int ocol = isA ? head * 128 : 1024 + head * 128;
    const int kcol = isA ? OFF_AK + hh * 128 : OFF_NK + hh * 128, vcol = isA ? OFF_AV + hh * 128 : OFF_NV + hh * 128;
    const int NT = kind == 0 ? 9 : (kind == 1 ? 15 : 4);
    const int krow0 = kind == 1 ? min(max(blk * 4 - 4, 0), 117) : 0;
    const int kp00 = blk * 64 - 128;
    if (kind == 1) { if (tid < 465) tab[tid] = rpb[head * 465 + tid] * LOG2E; }
    bf16x8 qr[8];
    { const bf16* Qw = ACT + (size_t)(qrow0 + r32) * ACTW + qcolofs + hi * 8;
#pragma unroll
      for (int d0 = 0; d0 < 8; ++d0) qr[d0] = *(const bf16x8*)(Qw + d0 * 16); }
    float m_reg, l_reg;
    if (isA) { m_reg = sink[head] * LOG2E; l_reg = 1.f; } else { m_reg = -1e30f; l_reg = 0.f; }
    f32x16 o[4] = {};
    const int sr = tid >> 4, sc = (tid & 15) * 8, vst0 = v_st(sr, sc), vst1 = v_st(32 + sr, sc);
    const int vb0 = (int)(unsigned)(uintptr_t)V_lds + v_rd_base(lane);
    bf16x8 vs0, vs1, ks0, ks1;
#define GROW(j, r) ((j) < 4 ? (size_t)(TL + b * CTXL + (j) * 64 + (r)) : (kind == 0 ? (size_t)(b * SEQ + min(max(kp00 + ((j) - 4) * 64 + (r), 0), SEQ - 1)) : (size_t)(b * SEQ + (krow0 + (j) - 4) * 64 + (r))))
#define SLOAD(j) do { const bf16* r0p = ACT + GROW((j), sr) * ACTW + sc; const bf16* r1p = ACT + GROW((j), 32 + sr) * ACTW + sc; \
        vs0 = *(const bf16x8*)(r0p + vcol); vs1 = *(const bf16x8*)(r1p + vcol); ks0 = *(const bf16x8*)(r0p + kcol); ks1 = *(const bf16x8*)(r1p + kcol); } while (0)
#define SWRITE(bb) do { *(LAS bf16x8*)(V_lds + (bb) * SHM_V + vst0) = vs0; *(LAS bf16x8*)(V_lds + (bb) * SHM_V + vst1) = vs1; const int kc = sc * 2; \
        *(LAS bf16x8*)(K_lds + (bb) * SHM_K + KSWZ(sr, kc)) = ks0; *(LAS bf16x8*)(K_lds + (bb) * SHM_K + KSWZ(32 + sr, kc)) = ks1; } while (0)
    SLOAD(0); SWRITE(0); __syncthreads();
    const int qpos = blk * 64 + (wid & 1) * 32 + r32;
    const int qgr = blk * 4 + (wid >> 1), qgc = (wid & 1) * 32 + r32;
    const int rs = min(max(qgr - 4, 0), 120), cs = min(max(qgc - 8, 0), 48);
    const int rsw = __builtin_amdgcn_readfirstlane(rs);
    for (int j = 0; j < NT; ++j) {
        const int cur = j & 1;
        if (j + 1 < NT) SLOAD(j + 1);
        const bool active = !(kind == 1 && j >= 4 && ((krow0 + j - 4 < rsw) || (krow0 + j - 4 >= rsw + 8)));
        if (active) {
        f32x16 p0, p1;
        SBAR(); qkt(p0, p1, K_lds + cur * SHM_K, qr, r32, hi);
        if (j >= 4) {
            int hiv = hi; asm volatile("" : "+v"(hiv));
            if (kind == 0) { const int kp0 = kp00 + (j - 4) * 64;
#pragma unroll
                for (int r = 0; r < 16; ++r) { const int kpa = kp0 + crow(r, hiv), kpb = kpa + 32;
                    const bool oka = ((unsigned)kpa < (unsigned)SEQ) && (kpa - qpos <= 128) && (qpos - kpa <= 128);
                    const bool okb = ((unsigned)kpb < (unsigned)SEQ) && (kpb - qpos <= 128) && (qpos - kpb <= 128);
                    p0[r] = oka ? p0[r] : -1e30f; p1[r] = okb ? p1[r] : -1e30f; }
            } else { const int keyrow = krow0 + j - 4; const bool rowok = (keyrow >= rs) && (keyrow < rs + 8);
                const int dr = min(max(keyrow - qgr + 7, 0), 14); const LAS float* trow = tab + dr * 31;
#pragma unroll
                for (int r = 0; r < 16; ++r) { const int ka = crow(r, hiv);
                    const bool oka = rowok && ((unsigned)(ka - cs) < 16u);
                    const float ba = trow[min(max(ka - qgc + 15, 0), 30)];
                    p0[r] = oka ? p0[r] + ba : -1e30f; }
                asm volatile("" ::: "memory");
#pragma unroll
                for (int r = 0; r < 16; ++r) { const int kb2 = crow(r, hiv) + 32;
                    const bool okb = rowok && ((unsigned)(kb2 - cs) < 16u);
                    const float bb = trow[min(max(kb2 - qgc + 15, 0), 30)];
                    p1[r] = okb ? p1[r] + bb : -1e30f; }
            }
        }
        float pmax = p0[0];
#pragma unroll
        for (int r = 1; r < 16; ++r) pmax = fmaxf(pmax, p0[r]);
#pragma unroll
        for (int r = 0; r < 16; ++r) pmax = fmaxf(pmax, p1[r]);
        { auto rr = __builtin_amdgcn_permlane32_swap(__float_as_uint(pmax), __float_as_uint(pmax), false, false); pmax = fmaxf(__uint_as_float(rr[0]), __uint_as_float(rr[1])); }
        float mn, alpha;
        if (__all(pmax - m_reg <= THR)) { mn = m_reg; alpha = 1.f; }
        else { mn = fmaxf(m_reg, pmax); alpha = fast_exp2(m_reg - mn); m_reg = mn; }
#pragma unroll
        for (int r = 0; r < 16; ++r) { p0[r] = fast_exp2(p0[r] - mn); p1[r] = fast_exp2(p1[r] - mn); }
        float ps = 0.f;
#pragma unroll
        for (int r = 0; r < 16; ++r) ps += p0[r];
#pragma unroll
        for (int r = 0; r < 16; ++r) ps += p1[r];
        { auto rr = __builtin_amdgcn_permlane32_swap(__float_as_uint(ps), __float_as_uint(ps), false, false); ps = __uint_as_float(rr[0]) + __uint_as_float(rr[1]); }
        l_reg = l_reg * alpha + ps;
        bf16x8 pa0, pa1, pa2, pa3;
#define PK4(P, BASE, OUT) do { unsigned a0 = cvt_pk_bf16(P[BASE + 0], P[BASE + 1]), a1 = cvt_pk_bf16(P[BASE + 2], P[BASE + 3]); \
        unsigned b0 = cvt_pk_bf16(P[BASE + 4], P[BASE + 5]), b1 = cvt_pk_bf16(P[BASE + 6], P[BASE + 7]); \
        auto r0 = __builtin_amdgcn_permlane32_swap(a0, b0, false, false); auto r1 = __builtin_amdgcn_permlane32_swap(a1, b1, false, false); \
        u32x4 w = {r0[0], r1[0], r0[1], r1[1]}; OUT = __builtin_bit_cast(bf16x8, w); } while (0)
        PK4(p0, 0, pa0); PK4(p0, 8, pa1); PK4(p1, 0, pa2); PK4(p1, 8, pa3);
#undef PK4
        if (__any(alpha < 1.f)) { if (hi == 0) al_l[r32] = alpha; asm volatile("s_waitcnt lgkmcnt(0)" ::: "memory");
#pragma unroll
            for (int d = 0; d < 4; ++d)
#pragma unroll
                for (int r = 0; r < 16; ++r) o[d][r] *= al_l[crow(r, hi)]; }
        SBAR();
        { const int vb = vb0 + cur * SHM_V; pv_one<0>(o[0], vb, pa0, pa1, pa2, pa3); pv_one<1>(o[1], vb, pa0, pa1, pa2, pa3); pv_one<2>(o[2], vb, pa0, pa1, pa2, pa3); pv_one<3>(o[3], vb, pa0, pa1, pa2, pa3); }
        }
        if (j + 1 < NT) SWRITE((j + 1) & 1);
        __syncthreads();
    }
    if (hi == 0) li_l[r32] = l_reg;
    asm volatile("s_waitcnt lgkmcnt(0)" ::: "memory");
    bf16* Ow = YC + (size_t)qrow0 * DM + ocol + r32;
    int hie = hi; asm volatile("" : "+v"(hie));
#pragma unroll
    for (int r = 0; r < 16; ++r) { const int orow = crow(r, hie); const float rl = fast_rcp(li_l[orow]);
#pragma unroll
        for (int d0 = 0; d0 < 4; ++d0) { const float v = o[d0][r] * rl; Ow[(size_t)orow * DM + d0 * 32] = (bf16)(cvt_pk_bf16(v, v) & 0xffffu); } }
#undef SLOAD
#undef SWRITE
#undef GROW
}
}

struct Args { const float* in[22]; float* out; unsigned char* ws; int ph_lo, ph_hi; };

struct Frame {
    LAS unsigned char* lds; int tid, lane, wave, G, c;
    unsigned char* ws;
    const float *x, *cvec, *ctx, *c_ctx, *w_mod, *b_mod, *g_mix, *w_in, *a_sink, *na_rpb, *w_pool, *pool_scale, *w_fnet, *w_branch, *w_out, *g_ffn, *w_ff_gate, *w_ff_val, *ff_conv_w, *ff_conv_b, *w_ff_down, *g_final;
    float* out;
};

__device__ __forceinline__ int map_row(int kind, int n) {
    if (kind == 1) { if (n < 1280) { const int head = n >> 7, d = n & 127, hf = d >> 6, i = d & 63; const int p = (i < 32) ? 2 * i : 2 * (i - 32) + 1; return head * 128 + hf * 64 + p; } return n; }
    if (kind == 2) return (n >> 7) * 256 + (n & 127);
    if (kind == 3) return (n >> 7) * 256 + 128 + (n & 127);
    return n;
}
__device__ __forceinline__ void tr_item(const float* __restrict__ W, int ldw, int nblk, int item, bf16* __restrict__ WT, int ldt, int kofs, int mapkind, const float* __restrict__ kscale, LAS float* scr, int lane, unsigned* cmax = nullptr, int cbase = 0) {
    const int kb = item / nblk, nb = item - kb * nblk, k0 = 64 * kb, n0 = 32 * nb;
    float wv[32];
#pragma unroll
    for (int i = 0; i < 32; ++i) { const int kk = 2 * i + (lane >> 5); wv[i] = W[(size_t)(k0 + kk) * ldw + n0 + (lane & 31)]; }
    if (kscale) {
#pragma unroll
        for (int i = 0; i < 32; ++i) wv[i] *= kscale[k0 + 2 * i + (lane >> 5)]; }
    if (cmax != nullptr && n0 >= cbase) {
        float mx = 0.f;
#pragma unroll
        for (int i = 0; i < 32; ++i) mx = fmaxf(mx, fabsf(wv[i]));
        mx = fmaxf(mx, __shfl_xor(mx, 32));
        if (lane < 32) atomicMax(cmax + (n0 - cbase) + lane, __float_as_uint(mx));
    }
#pragma unroll
    for (int i = 0; i < 32; ++i) { const int kk = 2 * i + (lane >> 5); scr[kk * 33 + (lane & 31)] = wv[i]; }
    LDS_WAIT(); asm volatile("" ::: "memory");
    const int cch = lane & 7;
#pragma unroll
    for (int j = 0; j < 4; ++j) { const int n = (lane >> 3) + 8 * j; const LAS float* s = scr + (8 * cch) * 33 + n;
        u32x4 o; o.x = cvt_pk_bf16(s[0 * 33], s[1 * 33]); o.y = cvt_pk_bf16(s[2 * 33], s[3 * 33]); o.z = cvt_pk_bf16(s[4 * 33], s[5 * 33]); o.w = cvt_pk_bf16(s[6 * 33], s[7 * 33]);
        *(u32x4*)(WT + (size_t)map_row(mapkind, n0 + n) * ldt + kofs + k0 + 8 * cch) = o; }
    LDS_WAIT(); asm volatile("" ::: "memory");
}

__device__ __forceinline__ void phase_prologue(Frame& F, bool do_mod) {
    const int gw = F.c * NWAVES + F.wave, NGW = F.G * NWAVES, lane = F.lane;
    unsigned char* ws = F.ws;
    LAS float* sv = (LAS float*)(F.lds + 73728);
    for (int i = F.tid; i < 3 * DM; i += NWAVES * 64) { const int v = i / DM, k = i - v * DM; const float cc = v < 2 ? F.cvec[v * DM + k] : F.c_ctx[k]; sv[i] = cc * sigmoidf_(cc); }
    __syncthreads();
    float* MOD = (float*)(ws + WS_MOD);
    if (do_mod) for (int it = F.wave * F.G + F.c; it < 2 * 96 * 16; it += NGW) {
        const int l = it / (96 * 16), r = it - l * 96 * 16, cbk = r >> 4, kc = r & 15;
        const int col = cbk * 256 + lane * 4, k0 = kc * 256;
        const float* Wp = F.w_mod + (size_t)l * DM * MODW + (size_t)k0 * MODW + col;
        f32x4 a0 = {0.f, 0.f, 0.f, 0.f}, a1 = a0, a2 = a0;
#pragma unroll 8
        for (int k = 0; k < 256; ++k) { const f32x4 w = *(const f32x4*)(Wp + (size_t)k * MODW); const float s0 = sv[k0 + k], s1 = sv[DM + k0 + k], s2 = sv[2 * DM + k0 + k]; a0 += w * s0; a1 += w * s1; a2 += w * s2; }
        if (kc == 0) { const f32x4 bb = *(const f32x4*)(F.b_mod + (size_t)l * MODW + col); a0 += bb; a1 += bb; a2 += bb; }
        float* pp = (float*)(ws + WS_PART) + ((size_t)(l * 16 + kc) * 3) * MODW + col;
        *(f32x4*)pp = a0; *(f32x4*)(pp + MODW) = a1; *(f32x4*)(pp + 2 * MODW) = a2;
    }
    { float* rope = (float*)(ws + WS_ROPE);
      for (int i = gw * 64 + lane; i < 128 * 32; i += NGW * 64) { const int pos = i >> 5, fi = i & 31; const float inv = exp2f(-(float)fi * (13.287712379549449f / 32.0f)); float sn, cs; sincosf((float)pos * inv, &sn, &cs); rope[2 * i] = cs; rope[2 * i + 1] = sn; }
      bf16* tab1 = (bf16*)(ws + WS_TAB1);
      for (int i = gw * 64 + lane; i < 512 * 256; i += NGW * 64) { const int mp = i >> 8, cc = i & 255, part = mp >> 8, m = mp & 255; const float xr = (float)((m * cc) & 255) * (1.0f / 256.0f);
          const float v = part ? -__builtin_amdgcn_sinf(xr) : __builtin_amdgcn_cosf(xr); tab1[i] = (bf16)(cvt_pk_bf16(v * 0.0625f, 0.f) & 0xffffu); }
      bf16* dftc = (bf16*)(ws + WS_DFTC);
      for (int i = gw * 64 + lane; i < 256 * 512; i += NGW * 64) { const int k = i >> 9, cc = i & 511, part = cc >> 8, n = cc & 255; const float xr = (float)((k * n) & 255) * (1.0f / 256.0f);
          const float v = part ? __builtin_amdgcn_sinf(xr) : __builtin_amdgcn_cosf(xr); dftc[i] = (bf16)(cvt_pk_bf16(v * 0.0625f, 0.f) & 0xffffu); }
      bf16* dfta = (bf16*)(ws + WS_DFTA);
      const float sc = 0.011048543456039806f;
      for (int k = 1 + gw; k <= SEQ / 4; k += NGW) { bf16* rowp = dfta + (size_t)k * pg8::ZK;
          for (int s = 0; s < 16; ++s) { const int c0 = s * 512 + lane * 8; float v[8];
#pragma unroll
              for (int e = 0; e < 8; ++e) { const int cc = c0 + e, blk = cc >> 11, n = 2 * (cc & 2047) + (blk & 1); const float xr = (float)((k * n) & 8191) * (1.0f / 8192.0f);
                  v[e] = ((blk < 2) ? __builtin_amdgcn_cosf(xr) : __builtin_amdgcn_sinf(xr)) * sc; }
              u32x4 w; w.x = cvt_pk_bf16(v[0], v[1]); w.y = cvt_pk_bf16(v[2], v[3]); w.z = cvt_pk_bf16(v[4], v[5]); w.w = cvt_pk_bf16(v[6], v[7]); *(u32x4*)(rowp + c0) = w; } }
    }
    { f32x4* xd = (f32x4*)(ws + WS_X + (size_t)TL * DM * 4); const f32x4* xs = (const f32x4*)F.ctx; _Pragma("unroll 4") for (size_t i = (size_t)gw * 64 + lane; i < (size_t)TC * DM / 4; i += (size_t)NGW * 64) xd[i] = xs[i]; }
    { bf16* wp = (bf16*)(ws + WS_WPOOLB); for (size_t i = (size_t)gw * 64 + lane; i < (size_t)2 * 4 * 256 * 256; i += (size_t)NGW * 64) wp[i] = (bf16)(cvt_pk_bf16(F.w_pool[i], 0.f) & 0xffffu);
      bf16* wf = (bf16*)(ws + WS_WFNETB); for (size_t i = (size_t)gw * 64 + lane; i < (size_t)2 * 1024 * 1024; i += (size_t)NGW * 64) wf[i] = (bf16)(cvt_pk_bf16(F.w_fnet[i], 0.f) & 0xffffu); }
    LAS float* scr = (LAS float*)(F.lds + F.wave * 8704);
    constexpr int I_IN = 64 * 720, I_BR = 16 * 128, I_OUT = 64 * 128, I_UP = 64 * 344, I_DN = 172 * 128;
    constexpr int I_LAYER = I_IN + 4 * I_BR + I_OUT + 2 * I_UP + I_DN;
    for (int it = gw; it < 2 * I_LAYER; it += NGW) {
        const int l = it / I_LAYER; int r = it - l * I_LAYER;
        unsigned char* wl = ws + WS_WL + (size_t)l * WL_STRIDE;
        if (r < I_IN) { tr_item(F.w_in + (size_t)l * DM * NIN, NIN, 720, r, (bf16*)(wl + WL_IN), DM, 0, 1, nullptr, scr, lane, (unsigned*)(ws + WS_CM) + l * 16384, 6656); continue; } r -= I_IN;
        if (r < I_BR) { tr_item(F.w_branch + ((size_t)l * 4 + 0) * 1024 * DM, DM, 128, r, (bf16*)(wl + WL_M), DM, 0, 0, nullptr, scr, lane); continue; } r -= I_BR;
        if (r < I_BR) { tr_item(F.w_branch + ((size_t)l * 4 + 1) * 1024 * DM, DM, 128, r, (bf16*)(wl + WL_M), DM, 1024, 0, nullptr, scr, lane); continue; } r -= I_BR;
        if (r < I_BR) { tr_item(F.w_branch + ((size_t)l * 4 + 2) * 1024 * DM, DM, 128, r, (bf16*)(ws + WS_WB2ST) + (size_t)l * DM * 1024, 1024, 0, 0, F.pool_scale + l * 1024, scr, lane); continue; } r -= I_BR;
        if (r < I_BR) { tr_item(F.w_branch + ((size_t)l * 4 + 3) * 1024 * DM, DM, 128, r, (bf16*)(ws + WS_WB3T) + (size_t)l * DM * 1024, 1024, 0, 0, nullptr, scr, lane); continue; } r -= I_BR;
        if (r < I_OUT) { tr_item(F.w_out + (size_t)l * DM * DM, DM, 128, r, (bf16*)(wl + WL_OUT), DM, 0, 0, nullptr, scr, lane); continue; } r -= I_OUT;
        if (r < I_UP) { tr_item(F.w_ff_gate + (size_t)l * DM * DFF, DFF, 344, r, (bf16*)(wl + WL_UP), DM, 0, 2, nullptr, scr, lane, (unsigned*)(ws + WS_CM2) + l * DFF, 0); continue; } r -= I_UP;
        if (r < I_UP) { tr_item(F.w_ff_val + (size_t)l * DM * DFF, DFF, 344, r, (bf16*)(wl + WL_UP), DM, 0, 3, nullptr, scr, lane, (unsigned*)(ws + WS_CM3) + l * DFF, 0); continue; } r -= I_UP;
        tr_item(F.w_ff_down + (size_t)l * DFF * DM, DM, 128, r, (bf16*)(wl + WL_DN), DFF, 0, 0, nullptr, scr, lane);
    }
}

__device__ __forceinline__ float mod_from_parts(const float* __restrict__ part, int l, int v, int idx) {
    float s = 0.f;
#pragma unroll
    for (int kc = 0; kc < 16; ++kc) s += part[((size_t)(l * 16 + kc) * 3 + v) * MODW + idx];
    return s;
}
__device__ __forceinline__ void norm_rows(Frame& F, const float* __restrict__ src_lat, const float* src_ctx, const float* __restrict__ gvec, const float* __restrict__ modl, int sh_off, int sc_off, bf16* __restrict__ H, int nrows, const float* __restrict__ slab, float* xctx_out, unsigned* __restrict__ H8, float* __restrict__ SHs, const float* __restrict__ part = nullptr, int part_l = 0) {
    const int gw = F.wave * F.G + F.c, NGW = F.G * NWAVES, lane = F.lane;
    LAS float* LA = (LAS float*)F.lds;
    for (int i = F.tid; i < 3 * DM; i += NWAVES * 64) { const int v = i / DM, k = i - v * DM;
        const float sc = part ? mod_from_parts(part, part_l, v, sc_off + k) : modl[(size_t)v * MODW + sc_off + k], sh = part ? mod_from_parts(part, part_l, v, sh_off + k) : modl[(size_t)v * MODW + sh_off + k];
        LA[i] = gvec[k] * (sc + 1.0f); LA[3 * DM + i] = sh; }
    __syncthreads();
    if (gw < nrows) {
        f32x4 v[16];
        { const float* xr = (gw < TL ? src_lat + (size_t)gw * DM : src_ctx + (size_t)(gw - TL) * DM) + lane * 4;
#pragma unroll
          for (int j = 0; j < 16; ++j) v[j] = *(const f32x4*)(xr + 256 * j); }
        for (int row = gw; row < nrows; row += NGW) {
            const int nrow = row + NGW; f32x4 vn[16];
            if (nrow < nrows) { const float* xr = (nrow < TL ? src_lat + (size_t)nrow * DM : src_ctx + (size_t)(nrow - TL) * DM) + lane * 4;
#pragma unroll
                for (int j = 0; j < 16; ++j) vn[j] = *(const f32x4*)(xr + 256 * j); }
            if (slab != nullptr && row >= TL) {
                const float* sp = slab + (size_t)(row - TL) * DM + lane * 4;
#pragma unroll
                for (int p = 0; p < 8; ++p)
#pragma unroll
                    for (int j = 0; j < 16; ++j) v[j] += *(const f32x4*)(sp + (size_t)p * TC * DM + 256 * j);
                float* xo = xctx_out + (size_t)(row - TL) * DM + lane * 4;
#pragma unroll
                for (int j = 0; j < 16; ++j) *(f32x4*)(xo + 256 * j) = v[j];
            }
            float ss = 0.f;
#pragma unroll
            for (int j = 0; j < 16; ++j) ss += (v[j][0] * v[j][0] + v[j][1] * v[j][1]) + (v[j][2] * v[j][2] + v[j][3] * v[j][3]);
            const float rstd = rsqrtf(wave_sum(ss) * (1.0f / DM) + EPS);
            const int var = row < SEQ ? 0 : (row < TL ? 1 : 2);
            const LAS float* pa = LA + var * DM + lane * 4; const LAS float* pb = pa + 3 * DM;
            bf16* hp = H + (size_t)row * DM + lane * 4;
            float amax = 0.f;
#pragma unroll
            for (int j = 0; j < 16; ++j) { const f32x4 a = *(const LAS f32x4*)(pa + 256 * j), b = *(const LAS f32x4*)(pb + 256 * j);
                const f32x4 y = v[j] * rstd * a + b; if (H != nullptr) { u32x2 w; w.x = cvt_pk_bf16(y[0], y[1]); w.y = cvt_pk_bf16(y[2], y[3]); *(u32x2*)(hp + 256 * j) = w; }
                v[j] = y; amax = fmaxf(fmaxf(amax, fmaxf(fabsf(y[0]), fabsf(y[1]))), fmaxf(fabsf(y[2]), fabsf(y[3]))); }
            if (H8 != nullptr) {
#pragma unroll
                for (int o = 1; o < 64; o <<= 1) amax = fmaxf(amax, __shfl_xor(amax, o));
                amax = fmaxf(amax, 1e-20f); const float qs = 127.0f / amax;
                if (lane == 0) SHs[row] = amax * (1.0f / 127.0f);
                unsigned* qp = H8 + (size_t)row * (DM / 4) + lane;
#pragma unroll
                for (int j = 0; j < 16; ++j) { const int q0 = (int)__builtin_rintf(v[j][0] * qs), q1 = (int)__builtin_rintf(v[j][1] * qs), q2 = (int)__builtin_rintf(v[j][2] * qs), q3 = (int)__builtin_rintf(v[j][3] * qs);
                    qp[64 * j] = (unsigned)(q0 & 0xff) | ((unsigned)(q1 & 0xff) << 8) | ((unsigned)(q2 & 0xff) << 16) | ((unsigned)(q3 & 0xff) << 24); }
            }
            if (nrow < nrows) {
#pragma unroll
                for (int j = 0; j < 16; ++j) v[j] = vn[j]; }
        }
    }
    __syncthreads();
}
__device__ __forceinline__ void final_norm(Frame& F, const float* __restrict__ X) {
    const int gw = F.c * NWAVES + F.wave, NGW = F.G * NWAVES, lane = F.lane;
    f32x4 g[16];
#pragma unroll
    for (int j = 0; j < 16; ++j) g[j] = *(const f32x4*)(F.g_final + lane * 4 + 256 * j);
    if (gw < TL) {
        f32x4 v[16];
        { const float* xr = X + (size_t)gw * DM + lane * 4;
#pragma unroll
          for (int j = 0; j < 16; ++j) v[j] = *(const f32x4*)(xr + 256 * j); }
        for (int row = gw; row < TL; row += NGW) {
            const int nrow = row + NGW; f32x4 vn[16];
            if (nrow < TL) { const float* xr = X + (size_t)nrow * DM + lane * 4;
#pragma unroll
                for (int j = 0; j < 16; ++j) vn[j] = *(const f32x4*)(xr + 256 * j); }
            float ss = 0.f;
#pragma unroll
            for (int j = 0; j < 16; ++j) ss += (v[j][0] * v[j][0] + v[j][1] * v[j][1]) + (v[j][2] * v[j][2] + v[j][3] * v[j][3]);
            const float rstd = rsqrtf(wave_sum(ss) * (1.0f / DM) + EPS);
            float* __restrict__ op = F.out + (size_t)row * DM + lane * 4;
#pragma unroll
            for (int j = 0; j < 16; ++j) *(f32x4*)(op + 256 * j) = v[j] * rstd * g[j];
            if (nrow < TL) {
#pragma unroll
                for (int j = 0; j < 16; ++j) v[j] = vn[j]; }
        }
    }
}
__device__ __forceinline__ void pool_diff(Frame& F, const bf16* __restrict__ ACT, bf16* __restrict__ YC, int nrows) {
    const size_t nth = (size_t)F.G * NWAVES * 64, t0 = (size_t)(F.c * NWAVES + F.wave) * 64 + F.lane;
    for (size_t i = t0; i < (size_t)nrows * 128; i += nth) {
        const int row = (int)(i >> 7), ch = (int)(i & 127) * 8, g = ch >> 8, w = 2 << g;
        int t, n; if (row < TL) { t = row & (SEQ - 1); n = SEQ; } else { t = (row - TL) & 255; n = CTXL; }
        const int base = row - t;
        const int lo = max(t - w / 2, 0), hi = min(t + w / 2, n);
        u32x4 a[16];
#pragma unroll
        for (int q = 0; q < 16; ++q) { const int tq = min(lo + q, n - 1); a[q] = *(const u32x4*)(ACT + (size_t)(base + tq) * ACTW + OFF_PU + ch); }
        const u32x4 c = *(const u32x4*)(ACT + (size_t)row * ACTW + OFF_PU + ch);
        float s[8] = {0.f, 0.f, 0.f, 0.f, 0.f, 0.f, 0.f, 0.f};
#pragma unroll
        for (int q = 0; q < 16; ++q) { const float wq = (lo + q < hi) ? 1.0f : 0.0f;
            s[0] += wq * bflo(a[q].x); s[1] += wq * bfhi(a[q].x); s[2] += wq * bflo(a[q].y); s[3] += wq * bfhi(a[q].y); s[4] += wq * bflo(a[q].z); s[5] += wq * bfhi(a[q].z); s[6] += wq * bflo(a[q].w); s[7] += wq * bfhi(a[q].w); }
        const float inv = 1.0f / (float)(hi - lo);
        u32x4 o; o.x = cvt_pk_bf16(s[0] * inv - bflo(c.x), s[1] * inv - bfhi(c.x)); o.y = cvt_pk_bf16(s[2] * inv - bflo(c.y), s[3] * inv - bfhi(c.y));
        o.z = cvt_pk_bf16(s[4] * inv - bflo(c.z), s[5] * inv - bfhi(c.z)); o.w = cvt_pk_bf16(s[6] * inv - bflo(c.w), s[7] * inv - bfhi(c.w));
        *(u32x4*)(YC + (size_t)row * DM + 2048 + ch) = o;
    }
}

__device__ __forceinline__ void quant_gate_weights(Frame& F) {
    const int gw = F.c * NWAVES + F.wave, NGW = F.G * NWAVES, lane = F.lane;
    unsigned char* ws = F.ws;
    for (int it = gw; it < 2 * NUP; it += NGW) {
        const int l = it / NUP, ri = it - l * NUP, j = (ri >> 8) * 128 + (ri & 127); const bool isval = (ri & 255) >= 128;
        const float cm = fmaxf(__uint_as_float(((const unsigned*)(ws + (isval ? WS_CM3 : WS_CM2)))[l * DFF + j]), 1e-30f), qs = 127.0f / cm;
        if (lane == 0) ((float*)(ws + WS_SWUP))[it] = cm * (1.0f / 127.0f);
        const bf16* src = (const bf16*)(ws + WS_WL + (size_t)l * WL_STRIDE + WL_UP) + (size_t)ri * DM + lane * 8;
        u32x2* dst = (u32x2*)(ws + (l == 0 ? WS_WV8 : WS_WGA8) + (size_t)ri * DM) + lane;
        u32x4 a[8];
#pragma unroll
        for (int jj = 0; jj < 8; ++jj) a[jj] = *(const u32x4*)(src + 512 * jj);
#pragma unroll
        for (int jj = 0; jj < 8; ++jj) { const float f[8] = {bflo(a[jj].x), bfhi(a[jj].x), bflo(a[jj].y), bfhi(a[jj].y), bflo(a[jj].z), bfhi(a[jj].z), bflo(a[jj].w), bfhi(a[jj].w)}; unsigned q[8];
#pragma unroll
            for (int e = 0; e < 8; ++e) q[e] = (unsigned)((int)__builtin_rintf(fminf(fmaxf(f[e] * qs, -127.f), 127.f)) & 0xff);
            u32x2 w; w.x = q[0] | (q[1] << 8) | (q[2] << 16) | (q[3] << 24); w.y = q[4] | (q[5] << 8) | (q[6] << 16) | (q[7] << 24); dst[64 * jj] = w; }
    }
    for (int it = gw; it < 2 * 16384; it += NGW) {
        const int l = it >> 14, n = it & 16383;
        const float cm = fmaxf(__uint_as_float(((const unsigned*)(ws + WS_CM))[it]), 1e-30f), qs = 127.0f / cm;
        if (lane == 0) ((float*)(ws + WS_SW))[it] = cm * (1.0f / 127.0f);
        const bf16* src = (const bf16*)(ws + WS_WL + (size_t)l * WL_STRIDE + WL_IN) + (size_t)(6656 + n) * DM + lane * 8;
        u32x2* dst = (u32x2*)(ws + WS_WG8 + ((size_t)l * 16384 + n) * DM) + lane;
        u32x4 a[8];
#pragma unroll
        for (int j = 0; j < 8; ++j) a[j] = *(const u32x4*)(src + 512 * j);
#pragma unroll
        for (int j = 0; j < 8; ++j) { const float f[8] = {bflo(a[j].x), bfhi(a[j].x), bflo(a[j].y), bfhi(a[j].y), bflo(a[j].z), bfhi(a[j].z), bflo(a[j].w), bfhi(a[j].w)}; unsigned q[8];
#pragma unroll
            for (int e = 0; e < 8; ++e) q[e] = (unsigned)((int)__builtin_rintf(fminf(fmaxf(f[e] * qs, -127.f), 127.f)) & 0xff);
            u32x2 w; w.x = q[0] | (q[1] << 8) | (q[2] << 16) | (q[3] << 24); w.y = q[4] | (q[5] << 8) | (q[6] << 16) | (q[7] << 24); dst[64 * j] = w; }
    }
}

__device__ __forceinline__ void dft_specials(Frame& F, const bf16* __restrict__ ZT, bf16* __restrict__ YC, float* __restrict__ E4, const bf16* __restrict__ ACT, const bf16* __restrict__ TAB1) {
    const int gw = F.c * NWAVES + F.wave, NGW = F.G * NWAVES, lane = F.lane;
    for (int it = gw; it < 8 * 256; it += NGW) {
        const int z = it >> 8, ch = it & 255, b = z >> 2, g = z & 3;
        const bf16* zr = ZT + ((size_t)z * 256 + ch) * pg8::ZK;
        u32x4 ve[4], vo[4];
#pragma unroll
        for (int j = 0; j < 4; ++j) { ve[j] = *(const u32x4*)(zr + (size_t)(j * 64 + lane) * 8); vo[j] = *(const u32x4*)(zr + 2048 + (size_t)(j * 64 + lane) * 8); }
        float e4;
        { const unsigned* up = (const unsigned*)(ACT + (size_t)(b * SEQ + SEQ / 2) * ACTW + OFF_FU + g * 256) + lane * 2; const unsigned* tp = (const unsigned*)(TAB1 + (size_t)ch * 256) + lane * 2;
          const unsigned u0 = up[0], u1 = up[1], t0 = tp[0], t1 = tp[1];
          e4 = wave_sum((bflo(u0) * bflo(t0) + bfhi(u0) * bfhi(t0)) + (bflo(u1) * bflo(t1) + bfhi(u1) * bfhi(t1))); }
        float se = 0.f, so = 0.f;
#pragma unroll
        for (int j = 0; j < 4; ++j) { se += (bflo(ve[j].x) + bfhi(ve[j].x)) + (bflo(ve[j].y) + bfhi(ve[j].y)) + (bflo(ve[j].z) + bfhi(ve[j].z)) + (bflo(ve[j].w) + bfhi(ve[j].w));
            so += (bflo(vo[j].x) + bfhi(vo[j].x)) + (bflo(vo[j].y) + bfhi(vo[j].y)) + (bflo(vo[j].z) + bfhi(vo[j].z)) + (bflo(vo[j].w) + bfhi(vo[j].w)); }
        se = wave_sum(se) + e4; so = wave_sum(so);
        if (lane == 0) { const float sc = 0.011048543456039806f; bf16* yb = YC + (size_t)b * SEQ * DM + 3072 + g * 256 + ch;
            yb[0] = (bf16)(cvt_pk_bf16((se + so) * sc, 0.f) & 0xffffu); yb[(size_t)(SEQ / 2) * DM] = (bf16)(cvt_pk_bf16((se - so) * sc, 0.f) & 0xffffu); E4[it] = e4 * sc; }
    }
}
__device__ __forceinline__ void dft_combine(Frame& F, const float* __restrict__ CS, const float* __restrict__ E4, bf16* __restrict__ YC) {
    const int gw = F.c * NWAVES + F.wave, NGW = F.G * NWAVES, lane = F.lane;
    const size_t PS = (size_t)8 * 2048 * 256;
    const size_t nth = (size_t)NGW * 64, t0 = (size_t)gw * 64 + lane, NI = (size_t)8 * 2048 * 32;
    for (size_t i = t0; i < NI; i += nth) {
        const int ch = (int)(i & 31) * 8, r = (int)(i >> 5) & 2047, z = (int)(i >> 16), b = z >> 2, g = z & 3, k = r + 1;
        const size_t so = ((size_t)z * 2048 + r) * 256 + ch;
        f32x4 v[4][2], e[2];
#pragma unroll
        for (int p = 0; p < 4; ++p) { v[p][0] = *(const f32x4*)(CS + p * PS + so); v[p][1] = *(const f32x4*)(CS + p * PS + so + 4); }
        e[0] = *(const f32x4*)(E4 + z * 256 + ch); e[1] = *(const f32x4*)(E4 + z * 256 + ch + 4);
        const float sg = (k & 1) ? -1.0f : 1.0f;
        u32x4 o[4];
        { f32x4 a1[2], a2[2], b1[2], b2[2];
#pragma unroll
          for (int h = 0; h < 2; ++h) { const f32x4 q = e[h] * sg; a1[h] = v[0][h] + v[1][h] + q; a2[h] = v[0][h] - v[1][h] + q; b1[h] = v[2][h] + v[3][h]; b2[h] = v[3][h] - v[2][h]; }
          const f32x4 y0[2] = {a1[0] + b1[0], a1[1] + b1[1]}, y1[2] = {a1[0] - b1[0], a1[1] - b1[1]}, y2[2] = {a2[0] + b2[0], a2[1] + b2[1]}, y3[2] = {a2[0] - b2[0], a2[1] - b2[1]};
          o[0].x = cvt_pk_bf16(y0[0][0], y0[0][1]); o[0].y = cvt_pk_bf16(y0[0][2], y0[0][3]); o[0].z = cvt_pk_bf16(y0[1][0], y0[1][1]); o[0].w = cvt_pk_bf16(y0[1][2], y0[1][3]);
          o[1].x = cvt_pk_bf16(y1[0][0], y1[0][1]); o[1].y = cvt_pk_bf16(y1[0][2], y1[0][3]); o[1].z = cvt_pk_bf16(y1[1][0], y1[1][1]); o[1].w = cvt_pk_bf16(y1[1][2], y1[1][3]);
          o[2].x = cvt_pk_bf16(y2[0][0], y2[0][1]); o[2].y = cvt_pk_bf16(y2[0][2], y2[0][3]); o[2].z = cvt_pk_bf16(y2[1][0], y2[1][1]); o[2].w = cvt_pk_bf16(y2[1][2], y2[1][3]);
          o[3].x = cvt_pk_bf16(y3[0][0], y3[0][1]); o[3].y = cvt_pk_bf16(y3[0][2], y3[0][3]); o[3].z = cvt_pk_bf16(y3[1][0], y3[1][1]); o[3].w = cvt_pk_bf16(y3[1][2], y3[1][3]); }
        bf16* yb = YC + (size_t)b * SEQ * DM + 3072 + g * 256 + ch;
        *(u32x4*)(yb + (size_t)k * DM) = o[0];
        *(u32x4*)(yb + (size_t)(SEQ - k) * DM) = o[1];
        if (k < SEQ / 4) { *(u32x4*)(yb + (size_t)(SEQ / 2 - k) * DM) = o[2]; *(u32x4*)(yb + (size_t)(SEQ / 2 + k) * DM) = o[3]; }
    }
}

__device__ __forceinline__ void merge_ctx_sum(Frame& F, const float* __restrict__ slab, bf16* __restrict__ MG) {
    const size_t nth = (size_t)F.G * NWAVES * 64, t0 = (size_t)(F.c * NWAVES + F.wave) * 64 + F.lane, NI = (size_t)TC * DM / 8;
    for (size_t i = t0; i < NI; i += nth) {
        f32x4 a0 = *(const f32x4*)(slab + i * 8), a1 = *(const f32x4*)(slab + i * 8 + 4);
        f32x4 v[7][2];
#pragma unroll
        for (int p = 1; p < 8; ++p) { v[p - 1][0] = *(const f32x4*)(slab + (size_t)p * TC * DM + i * 8); v[p - 1][1] = *(const f32x4*)(slab + (size_t)p * TC * DM + i * 8 + 4); }
#pragma unroll
        for (int p = 0; p < 7; ++p) { a0 += v[p][0]; a1 += v[p][1]; }
        u32x4 w; w.x = cvt_pk_bf16(a0[0], a0[1]); w.y = cvt_pk_bf16(a0[2], a0[3]); w.z = cvt_pk_bf16(a1[0], a1[1]); w.w = cvt_pk_bf16(a1[2], a1[3]);
        *(u32x4*)(MG + (size_t)TL * DM + i * 8) = w;
    }
}

constexpr int N_PHASES = 24;
typedef const char __attribute__((address_space(4)))* kptr_t;
__device__ __forceinline__ void make_frame(Frame& F, unsigned char* lds_raw) {
    kptr_t kp = (kptr_t)__builtin_amdgcn_kernarg_segment_ptr(); asm volatile("" : "+s"(kp));
    int tid = threadIdx.x; asm volatile("" : "+v"(tid));
    F.lds = (LAS unsigned char*)lds_raw;
    F.tid = tid; F.lane = tid & 63; F.wave = __builtin_amdgcn_readfirstlane(tid >> 6);
    F.G = gridDim.x; F.c = blockIdx.x;
#define KA(i) (*(const float* const __attribute__((address_space(4)))*)(kp + 8 * (i)))
    F.x = KA(0); F.cvec = KA(1); F.ctx = KA(2); F.c_ctx = KA(3); F.w_mod = KA(4); F.b_mod = KA(5); F.g_mix = KA(6); F.w_in = KA(7);
    F.a_sink = KA(8); F.na_rpb = KA(9); F.w_pool = KA(10); F.pool_scale = KA(11); F.w_fnet = KA(12); F.w_branch = KA(13); F.w_out = KA(14);
    F.g_ffn = KA(15); F.w_ff_gate = KA(16); F.w_ff_val = KA(17); F.ff_conv_w = KA(18); F.ff_conv_b = KA(19); F.w_ff_down = KA(20); F.g_final = KA(21);
    F.out = (float*)KA(22); F.ws = (unsigned char*)KA(23);
#undef KA
}
static_assert(WS_DFTA + (size_t)SEQ * pg8::ZK * 2 <= WS_WV8 && WS_WV8 + (size_t)2 * DFF * DM <= WS_WL, "WV8 sits behind DFTA");
static_assert(sizeof(Args) == 200, "Args layout: in[22] at 0, out at 176, ws at 184, ph_lo 192, ph_hi 196");

__global__ void __launch_bounds__(NWAVES * 64, 2) fwd(Args args) {
    extern __shared__ __attribute__((aligned(16))) unsigned char lds_raw[];
    {   LAS unsigned char* l3 = (LAS unsigned char*)lds_raw;
        for (int u = threadIdx.x; u < (LDS_BYTES - LDSCTL_OFF) / 4; u += NWAVES * 64) ((LAS unsigned*)(l3 + LDSCTL_OFF))[u] = 0u;
        __syncthreads(); }
    XcdBarrier bar; bar.bar = (unsigned*)((gu32*)(args.ws + WS_CTL) + CW_BAR); bar.x = 0; bar.st = nullptr;
    if (MK_N_LAUNCHES == 1) bar = xcd_barrier_post((unsigned*)((gu32*)(args.ws + WS_CTL) + CW_BAR), (volatile LAS unsigned*)((LAS unsigned char*)lds_raw + MISC_OFF) + 8);
    const int lo = args.ph_lo, hi = args.ph_hi;
#ifndef SITEMASK
#define SITEMASK 0xffff
#endif
#define SITE_ON(s) (((SITEMASK) >> (s)) & 1)
#ifndef MIXMASK
#define MIXMASK 7
#endif
#ifndef PROBE_DUP
#define PROBE_DUP 0
#endif
#ifndef UPV8_MASK
#define UPV8_MASK 3
#endif
#define REPS(s) (1 + (((PROBE_DUP) >> (s)) & 1))
#define IN(k) (lo <= (k) && (k) < hi)
#ifndef PROBE_BAR
#define PROBE_BAR 0
#endif
#define SEAM(k) do { if (IN(k) && IN((k) + 1)) { if (MK_N_LAUNCHES == 1) { xcd_barrier(bar); if (PROBE_BAR) { xcd_barrier(bar); xcd_barrier(bar); } } } } while (0)
#define SITE_VARS() Frame F; make_frame(F, lds_raw); unsigned char* ws = F.ws; const int G = F.G, c = F.c; (void)G; (void)c; \
    float* MOD = (float*)(ws + WS_MOD); bf16* H = (bf16*)(ws + WS_H); bf16* ACT = (bf16*)(ws + WS_ACT); bf16* MG = (bf16*)(ws + WS_MG); bf16* Gt = (bf16*)(ws + WS_G); bf16* U = (bf16*)(ws + WS_U); \
    bf16* YC = (bf16*)(ws + WS_YCAT); bf16* ZT = (bf16*)(ws + WS_ZT); bf16* ZTC = (bf16*)(ws + WS_ZTC); float* X = (float*)(ws + WS_X); \
    unsigned char* wl = ws + WS_WL + (size_t)l * WL_STRIDE; const float* modl = MOD + (size_t)l * 3 * MODW; \
    const float* xs_lat = l == 0 ? F.x : X; const float* xs_ctx = l == 0 ? F.ctx : X + (size_t)TL * DM; \
    (void)H; (void)ACT; (void)MG; (void)Gt; (void)U; (void)YC; (void)ZT; (void)ZTC; (void)X; (void)wl; (void)modl; (void)xs_lat; (void)xs_ctx;

    if (SITE_ON(0) && IN(0)) { for (int rep = 0; rep < REPS(0); ++rep) { Frame F; make_frame(F, lds_raw); phase_prologue(F, rep == 0); __syncthreads(); } }
    SEAM(0);

    for (int l = 0; l < 2; ++l) {
        const int p0 = l == 0 ? 1 : 12;
        const bool last = (l == 1);
        const int nMrows = last ? 64 : 66;

        if (SITE_ON(1) && IN(p0)) {
            { SITE_VARS(); norm_rows(F, xs_lat, xs_ctx, F.g_mix + l * DM, modl, 0, DM, H, T, l == 0 ? nullptr : (const float*)(ws + WS_SLAB), X + (size_t)TL * DM, (unsigned*)(ws + WS_H8), (float*)(ws + WS_SH), l == 0 ? (const float*)(ws + WS_PART) : nullptr, 0); }
            if (l == 0) {
                { SITE_VARS(); const float* part = (const float*)(ws + WS_PART);
                  for (int i = (c * NWAVES + F.wave) * 64 + F.lane; i < 2 * 3 * MODW; i += G * NWAVES * 64) { const int ll = i / (3 * MODW), r = i - ll * 3 * MODW, v = r / MODW, idx = r - v * MODW; MOD[i] = mod_from_parts(part, ll, v, idx); } }
                { Frame F; make_frame(F, lds_raw); quant_gate_weights(F); }
                __syncthreads();
                { SITE_VARS(); pg8::SchedJob S; S.A = (const char*)(ws + WS_WB3T); S.B = (const char*)(ws + WS_WFNETB); S.nZ2 = 1; S.nM = 16; S.nN = 4; S.nTot = 2 * 64; S.hbB = 128L * 1024 * 2;
                  S.az1 = (size_t)DM * 1024 * 2; S.az2 = 0; S.am = (size_t)256 * 1024 * 2; S.bz1 = (size_t)1024 * 1024 * 2; S.bz2 = 0; S.bn = (size_t)256 * 1024 * 2;
                  S.oz1 = (long)(WL_STRIDE / 2); S.oz2 = 0; S.om = (long)256 * DM; S.on = 256;
                  pg8::EpiStore E{(bf16*)(ws + WS_WL + WL_M) + 3072, DM};
                  pg8::gemm_phase<pg8::EpiStore, pg8::SchedJob, true>(F.lds, 1024, 1024, 1024, S, E, G, c); }
                __syncthreads();
                { SITE_VARS(); pg8::SchedJob S; S.A = (const char*)(ws + WS_WB2ST); S.B = (const char*)(ws + WS_WPOOLB); S.nZ2 = 4; S.nM = 16; S.nN = 1; S.nTot = 8 * 16; S.hbB = 128L * 256 * 2;
                  S.az1 = (size_t)DM * 1024 * 2; S.az2 = 256 * 2; S.am = (size_t)256 * 1024 * 2; S.bz1 = (size_t)4 * 65536 * 2; S.bz2 = (size_t)65536 * 2; S.bn = 0;
                  S.oz1 = (long)(WL_STRIDE / 2); S.oz2 = 256; S.om = (long)256 * DM; S.on = 0;
                  pg8::EpiStore E{(bf16*)(ws + WS_WL + WL_M) + 2048, DM};
                  pg8::gemm_phase<pg8::EpiStore, pg8::SchedJob, true>(F.lds, 256, 1024, 256, S, E, G, c); }
            }
        }
        SEAM(p0);

        if (SITE_ON(2) && IN(p0 + 1)) for (int rep = 0; rep < REPS(2); ++rep) {
            SITE_VARS();
            { pg8::SchedRect S; S.A = (const char*)H; S.B = (const char*)(wl + WL_IN); S.nM = last ? 64 : 66; S.nN = 26; S.aS = (size_t)256 * DM * 2; S.bS = (size_t)256 * DM * 2; S.extra = last ? 20 : 0; S.t_c0 = 0; S.t_g = 0;
              pg8::EpiIn E{ACT, Gt, (const float*)(ws + WS_ROPE)};
              pg8::gemm_phase<pg8::EpiIn, pg8::SchedRect, true>(F.lds, DM, DM, DM, S, E, G, c); }
            __syncthreads();
            { SITE_VARS();
              pg8::SchedRect S; S.A = (const char*)(ws + WS_H8); S.B = (const char*)(ws + WS_WG8 + (size_t)l * 16384 * DM); S.nM = last ? 64 : 66; S.nN = 64; S.aS = (size_t)256 * DM; S.bS = (size_t)256 * DM; S.extra = 0; S.t_c0 = 184; S.t_g = (!last && G == 256) ? 72 : 0;
              pg8::EpiGate E{Gt, (const float*)(ws + WS_SH), (const float*)(ws + WS_SW) + l * 16384};
              pg8::gemm_phase<pg8::EpiGate, pg8::SchedRect, true>(F.lds, DM / 2, DM / 2, DM / 2, S, E, G, c); }
        }
        SEAM(p0 + 1);

        if (SITE_ON(3) && IN(p0 + 2)) for (int rep = 0; rep < REPS(3); ++rep) {
            if (MIXMASK & 1) { SITE_VARS(); pg8::SchedS1 S; S.A = (const char*)(ws + WS_TAB1); S.Ub = (const char*)(ACT + OFF_FU);
              pg8::EpiS1 E{ZT};
              pg8::gemm_phase<pg8::EpiS1, pg8::SchedS1, true>(F.lds, 256, 256, ACTW, S, E, G, c); }
            if ((MIXMASK & 1) && !last) { __syncthreads();
              SITE_VARS(); pg8::SchedJob S; S.A = (const char*)(ws + WS_TAB1); S.B = (const char*)(ACT + (size_t)TL * ACTW + OFF_FU); S.nZ2 = 4; S.nM = 2; S.nN = 1; S.nTot = 8 * 2; S.hbB = 128L * ACTW * 2;
              S.az1 = 0; S.az2 = 0; S.am = (size_t)256 * 256 * 2; S.bz1 = (size_t)CTXL * ACTW * 2; S.bz2 = 256 * 2; S.bn = 0;
              S.oz1 = (long)4 * 256 * 512; S.oz2 = (long)256 * 512; S.om = 256; S.on = 0;
              pg8::EpiStore E{ZTC, 512};
              pg8::gemm_phase<pg8::EpiStore, pg8::SchedJob, true>(F.lds, 256, 256, ACTW, S, E, G, G == 256 ? ((c + 192) & 255) : c); }
            __syncthreads();
            if (MIXMASK & 2) { SITE_VARS(); const int NU = last ? 1024 : 1056;
              for (int it = 0; ; ++it) {
                  int L = it * G + c;
                  if (G == 256 && it == 4) L = (c >= 128 && c < 160) ? 1024 + c - 128 : NU;
                  if (L >= NU) break;
                  int kind, b, hh, blk;
                  if (L < 512) { kind = 1; b = L >> 8; hh = (L >> 5) & 7; blk = L & 31; }
                  else if (L < 1024) { const int i = L - 512; kind = 0; b = i >> 8; hh = (i >> 7) & 1; blk = i & 127; }
                  else if (L < 1040) { const int i = L - 1024; kind = 2; b = i >> 3; hh = (i >> 2) & 1; blk = i & 3; }
                  else { const int i = L - 1040; kind = 3; b = i >> 3; hh = i & 7; blk = 0; }
                  att::attn_unit((LAS char*)F.lds, ACT, YC, F.a_sink + l * 8, F.na_rpb + (size_t)l * 8 * 465, kind, b, hh, blk);
              } }
            if (MIXMASK & 4) { SITE_VARS(); pool_diff(F, ACT, YC, last ? TL : T); }
        }
        SEAM(p0 + 2);

        if (SITE_ON(4) && IN(p0 + 3)) for (int rep = 0; rep < REPS(4); ++rep) {
            { SITE_VARS(); pg8::SchedDft S; S.A = (const char*)(ws + WS_DFTA); S.B = (const char*)ZT;
              pg8::EpiF32 E{(float*)(ws + WS_H)};
              pg8::gemm_phase<pg8::EpiF32, pg8::SchedDft, true>(F.lds, pg8::ZK, pg8::ZK, pg8::ZK, S, E, G, c); }
            { SITE_VARS(); dft_specials(F, ZT, YC, (float*)(ws + WS_H + 64 * MiB), ACT, (const bf16*)(ws + WS_TAB1)); }
            if (!last) { __syncthreads();
              SITE_VARS(); pg8::SchedJob S; S.A = (const char*)(ws + WS_DFTC); S.B = (const char*)ZTC; S.nZ2 = 4; S.nM = 1; S.nN = 1; S.nTot = 8; S.hbB = 128L * 512 * 2;
              S.az1 = 0; S.az2 = 0; S.am = 0; S.bz1 = (size_t)4 * 256 * 512 * 2; S.bz2 = (size_t)256 * 512 * 2; S.bn = 0;
              S.oz1 = (long)CTXL * DM; S.oz2 = 256; S.om = 0; S.on = 0;
              pg8::EpiStore E{YC + (size_t)TL * DM + 3072, DM};
              pg8::gemm_phase<pg8::EpiStore, pg8::SchedJob, true>(F.lds, 512, 512, 512, S, E, G, c); }
        }
        SEAM(p0 + 3);

        if (SITE_ON(11) && IN(p0 + 4)) { SITE_VARS(); dft_combine(F, (const float*)(ws + WS_H), (const float*)(ws + WS_H + 64 * MiB), YC); }
        SEAM(p0 + 4);

        if (SITE_ON(5) && IN(p0 + 5)) for (int rep = 0; rep < REPS(5); ++rep) {
            SITE_VARS();
            pg8::SchedSplit S; S.A = (const char*)YC; S.B = (const char*)(wl + WL_M); S.aS = (size_t)256 * DM * 2; S.bS = (size_t)256 * DM * 2; S.pairs = DM / 128; S.nctx = last ? 0 : 256;
            pg8::EpiMerge E{Gt, MG, (float*)(ws + WS_SLAB)};
            pg8::gemm_phase<pg8::EpiMerge, pg8::SchedSplit, true>(F.lds, DM, DM, DM, S, E, G, c);
        }
        SEAM(p0 + 5);

        if (SITE_ON(12) && IN(p0 + 6) && !last) { SITE_VARS(); merge_ctx_sum(F, (const float*)(ws + WS_SLAB), MG); }
        SEAM(p0 + 6);

        if (SITE_ON(6) && IN(p0 + 7)) for (int rep = 0; rep < REPS(6); ++rep) {
            SITE_VARS();
            pg8::SchedSplit S; S.A = (const char*)MG; S.B = (const char*)(wl + WL_OUT); S.aS = (size_t)256 * DM * 2; S.bS = (size_t)256 * DM * 2; S.pairs = DM / 128; S.nctx = last ? 0 : 256;
            pg8::EpiResid E{xs_lat, xs_ctx, (rep + 1 < REPS(6)) ? (float*)(ws + 2800 * MiB) : X, modl + 2 * DM, (float*)(ws + WS_SLAB)};
            pg8::gemm_phase<pg8::EpiResid, pg8::SchedSplit, true>(F.lds, DM, DM, DM, S, E, G, c);
        }
        SEAM(p0 + 7);

        if (SITE_ON(7) && IN(p0 + 8)) for (int rep = 0; rep < REPS(7); ++rep) { SITE_VARS(); norm_rows(F, X, X + (size_t)TL * DM, F.g_ffn + l * DM, modl, 3 * DM, 4 * DM, nullptr, last ? TL : T, last ? nullptr : (const float*)(ws + WS_SLAB), X + (size_t)TL * DM, (unsigned*)(ws + WS_H8), (float*)(ws + WS_SH)); }
        SEAM(p0 + 8);

        if (SITE_ON(8) && IN(p0 + 9)) for (int rep = 0; rep < REPS(8); ++rep) {
            SITE_VARS();
            pg8::SchedUp S; S.A = (const char*)(ws + WS_H8) - (size_t)DM; S.B = (const char*)(ws + (l == 0 ? WS_WV8 : WS_WGA8)); S.nM = last ? 66 : 68; S.nN = 86; S.aS = (size_t)252 * DM; S.bS = (size_t)256 * DM;
            pg8::EpiUp8 E{U, F.ff_conv_w + (size_t)l * 3 * DFF, F.ff_conv_b + (size_t)l * DFF, (const float*)(ws + WS_SH), (const float*)(ws + WS_SWUP) + (size_t)l * NUP};
            pg8::gemm_phase<pg8::EpiUp8, pg8::SchedUp, true>(F.lds, DM / 2, DM / 2, DM / 2, S, E, G, c);
        }
        SEAM(p0 + 9);

        if (SITE_ON(9) && IN(p0 + 10)) for (int rep = 0; rep < REPS(9); ++rep) {
            SITE_VARS();
            pg8::SchedSplit S; S.A = (const char*)U; S.B = (const char*)(wl + WL_DN); S.aS = (size_t)256 * DFF * 2; S.bS = (size_t)256 * DFF * 2; S.pairs = DFF / 128; S.nctx = last ? 0 : 256;
            pg8::EpiResid E{X, X + (size_t)TL * DM, (rep + 1 < REPS(9)) ? (float*)(ws + 2800 * MiB) : X, modl + 5 * DM, (float*)(ws + WS_SLAB)};
            pg8::gemm_phase<pg8::EpiResid, pg8::SchedSplit, true>(F.lds, DFF, DFF, DFF, S, E, G, c);
        }
        SEAM(p0 + 10);
    }
    if (SITE_ON(10) && IN(23)) { const int l = 1; SITE_VARS(); final_norm(F, X); }
#undef IN
#undef SEAM
}


#ifdef DBG_STOP
__global__ void dbg_dump(const unsigned char* ws, size_t off, int isf32, float* out) {
    const size_t n = (size_t)TL * DM;
    for (size_t i = (size_t)blockIdx.x * blockDim.x + threadIdx.x; i < n; i += (size_t)gridDim.x * blockDim.x)
        out[i] = isf32 ? ((const float*)(ws + off))[i] : bf2f(((const unsigned short*)(ws + off))[i]);
}
#endif
extern "C" void kernel_launch(void* const* d_in, const int* in_sizes, int n_in, void* d_out, int out_size, void* d_ws, size_t ws_size, hipStream_t stream) {
    static int grid = 0;
    if (grid == 0) {
        if (n_in != 22 || ws_size < WS_END) { fprintf(stderr, "kernel_launch: n_in %d ws %zu (need %zu)\n", n_in, ws_size, (size_t)WS_END); grid = -1; return; }
        int dev = 0, cus = 0;
        if (hipGetDevice(&dev) != hipSuccess || hipDeviceGetAttribute(&cus, hipDeviceAttributeMultiprocessorCount, dev) != hipSuccess) { grid = -1; return; }
        if (hipFuncSetAttribute((const void*)fwd, hipFuncAttributeMaxDynamicSharedMemorySize, LDS_BYTES) != hipSuccess) { fprintf(stderr, "kernel_launch: hipFuncSetAttribute failed\n"); grid = -1; return; }
        int per_cu = 0; (void)hipOccupancyMaxActiveBlocksPerMultiprocessor(&per_cu, (const void*)fwd, NWAVES * 64, LDS_BYTES); (void)hipGetLastError();
        grid = cus;
    }
    if (grid < 0) return;
    (void)hipMemsetAsync((char*)d_ws + WS_CTL, 0, CTL_ZERO_BYTES, stream);
    Args a{};
    for (int i = 0; i < 22; ++i) a.in[i] = (const float*)d_in[i];
    a.out = (float*)d_out; a.ws = (unsigned char*)d_ws;
#ifdef DBG_STOP
    for (int p = 0; p < DBG_STOP; ++p) { a.ph_lo = p; a.ph_hi = p + 1; hipLaunchKernelGGL(fwd, dim3(grid), dim3(NWAVES * 64), LDS_BYTES, stream, a); }
    hipLaunchKernelGGL(dbg_dump, dim3(2048), dim3(256), 0, stream, (const unsigned char*)d_ws, (size_t)DBG_OFF, (int)DBG_F32, (float*)d_out);
    return;
#endif
    if (MK_N_LAUNCHES == 1) { a.ph_lo = 0; a.ph_hi = N_PHASES; hipLaunchKernelGGL(fwd, dim3(grid), dim3(NWAVES * 64), LDS_BYTES, stream, a); }
    else { for (int p = 0; p < N_PHASES; ++p) { a.ph_lo = p; a.ph_hi = p + 1; hipLaunchKernelGGL(fwd, dim3(grid), dim3(NWAVES * 64), LDS_BYTES, stream, a); } }
}
```

```cpp
#include <hip/hip_runtime.h>
#include <cstdio>
#include <cstdint>

#ifndef MK_N_LAUNCHES
#define MK_N_LAUNCHES 1
#endif

#define GAS __attribute__((address_space(1)))
#define LAS __attribute__((address_space(3)))
typedef unsigned short bf16;
typedef short bf16x8 __attribute__((ext_vector_type(8)));
typedef short s16x4 __attribute__((ext_vector_type(4)));
typedef float f32x4 __attribute__((ext_vector_type(4)));
typedef float f32x2 __attribute__((ext_vector_type(2)));
typedef float f32x16 __attribute__((ext_vector_type(16)));
typedef unsigned u32x4 __attribute__((ext_vector_type(4)));
typedef unsigned u32x2 __attribute__((ext_vector_type(2)));
typedef int i32x4 __attribute__((ext_vector_type(4)));
typedef GAS unsigned gu32;

constexpr int DM = 4096, SEQ = 8192, NBATCH = 2, CTXL = 256;
constexpr int TL = NBATCH * SEQ;
constexpr int TC = NBATCH * CTXL;
constexpr int T = TL + TC;
constexpr int NIN = 23040, DFF = 11008, NUP = 2 * DFF, ACTW = 6656, GW = 16384;
constexpr int OFF_AQ = 0, OFF_AK = 1024, OFF_AV = 1280, OFF_NQ = 1536, OFF_NK = 2560, OFF_NV = 3584, OFF_PU = 4608, OFF_FU = 5632;
constexpr int MODW = 6 * DM;
constexpr float QSCALE = 0.08838834764831845f * 1.4426950408889634f;
constexpr float LOG2E = 1.4426950408889634f;
constexpr float EPS = 1e-6f;

constexpr size_t MiB = 1u << 20;
constexpr size_t WS_CTL = 0, CTL_ZERO_BYTES = 2 * MiB;
constexpr size_t WS_MOD = 1 * MiB;
constexpr size_t WS_CM3 = 1 * MiB + 896 * 1024;
constexpr size_t WS_CM2 = 1 * MiB + 768 * 1024;
constexpr size_t WS_CM = 1 * MiB + 640 * 1024;
constexpr size_t WS_ROPE = 2 * MiB;
constexpr size_t WS_TAB1 = 2 * MiB + 256 * 1024;
constexpr size_t WS_DFTC = 2 * MiB + 512 * 1024;
constexpr size_t WS_WPOOLB = 3 * MiB;
constexpr size_t WS_WFNETB = 4 * MiB;
constexpr size_t WS_WB2ST = 8 * MiB;
constexpr size_t WS_WB3T = 24 * MiB;
constexpr size_t WS_DFTA = 40 * MiB;
constexpr size_t WS_WL = 296 * MiB, WL_STRIDE = 504 * MiB;
constexpr size_t WL_IN = 0, WL_M = 180 * MiB, WL_OUT = 212 * MiB, WL_UP = 244 * MiB, WL_DN = 416 * MiB;
constexpr size_t WS_H = 1306 * MiB;
constexpr size_t WS_ACT = 1440 * MiB;
constexpr size_t WS_MG = WS_ACT;
constexpr size_t WS_G = 1656 * MiB;
constexpr size_t WS_U = WS_G;
constexpr size_t WS_YCAT = 2184 * MiB;
constexpr size_t WS_ZT = 2316 * MiB;
constexpr size_t WS_ZTC = 2380 * MiB;
constexpr size_t WS_X = 2382 * MiB;
constexpr size_t WS_SLAB = 2648 * MiB;
constexpr size_t WS_H8 = 2712 * MiB;
constexpr size_t WS_WG8 = 2780 * MiB;
constexpr size_t WS_SH = 2908 * MiB;
constexpr size_t WS_SW = 2908 * MiB + 256 * 1024;
constexpr size_t WS_WGA8 = 2910 * MiB;
constexpr size_t WS_SWG = 2908 * MiB + 512 * 1024;
constexpr size_t WS_WV8 = 172 * MiB;
constexpr size_t WS_SWUP = 2908 * MiB + 768 * 1024;
constexpr size_t WS_SWV = 2908 * MiB + 640 * 1024;
constexpr size_t WS_PART = 2998 * MiB;
constexpr size_t WS_END = 3008 * MiB;

constexpr int CW_TMO = 0;
constexpr int CW_BAR = 4096;

constexpr int RING_BYTES = 131072;
constexpr int LDSCTL_OFF = RING_BYTES, MISC_OFF = LDSCTL_OFF + 320;
constexpr int LDS_BYTES = 147456;
constexpr int NWAVES = 8;

#define RLX_AGENT __ATOMIC_RELAXED, __HIP_MEMORY_SCOPE_AGENT
#define LDS_WAIT() asm volatile("s_waitcnt lgkmcnt(0)" ::: "memory")
#define VM_WAIT() asm volatile("s_waitcnt vmcnt(0)" ::: "memory")
typedef __bf16 bf16x2_t __attribute__((ext_vector_type(2)));
__device__ __forceinline__ unsigned cvt_pk_bf16(float lo, float hi) { f32x2 f = {lo, hi}; bf16x2_t v = __builtin_convertvector(f, bf16x2_t); return __builtin_bit_cast(unsigned, v); }
__device__ __forceinline__ float bf2f(unsigned short b) { return __builtin_bit_cast(float, ((unsigned)b) << 16); }
__device__ __forceinline__ float bflo(unsigned w) { return __builtin_bit_cast(float, w << 16); }
__device__ __forceinline__ float bfhi(unsigned w) { return __builtin_bit_cast(float, w & 0xffff0000u); }
__device__ __forceinline__ float fast_exp2(float x) { return __builtin_amdgcn_exp2f(x); }
__device__ __forceinline__ float fast_rcp(float x) { return __builtin_amdgcn_rcpf(x); }
__device__ __forceinline__ float sigmoidf_(float x) { return fast_rcp(1.0f + fast_exp2(-x * LOG2E)); }
__device__ __forceinline__ float wave_sum(float v) {
#pragma unroll
    for (int o = 1; o < 64; o <<= 1) v += __shfl_xor(v, o);
    return v;
}

#define XB_TMO      128
#define XB_XCNT(j)  (256  + 64 * (j))
#define XB_XSUB(j)  (1280 + 64 * (j))
#define XB_XGEN(j)  (2304 + 64 * (j))
#define XB_TOP      3328
#define XB_TOPGEN   3392
#define XCD_BAR_WORDS 3456
#define XB_SPIN_CAP (1u << 18)
__device__ __forceinline__ unsigned xb_ld(unsigned* p)              { return __hip_atomic_load(p, __ATOMIC_RELAXED, __HIP_MEMORY_SCOPE_AGENT); }
__device__ __forceinline__ unsigned xb_add(unsigned* p, unsigned v) { return __hip_atomic_fetch_add(p, v, __ATOMIC_RELAXED, __HIP_MEMORY_SCOPE_AGENT); }
__device__ __forceinline__ unsigned xb_xcc_id() { return (unsigned)__builtin_amdgcn_s_getreg((3 << 11) | 20) & 0xFu; }
#define XB_SPIN(cond, bar) do { unsigned _sp = 0; while (cond) { __builtin_amdgcn_s_sleep(1); \
    if ((++_sp & 255u) == 0u) { if (xb_ld(&(bar)[XB_TMO])) break; if (_sp > XB_SPIN_CAP) { atomicAdd(&(bar)[XB_TMO], 1u); break; } } } } while (0)
struct XcdBarrier { unsigned* bar; unsigned x; volatile LAS unsigned* st; };
__device__ __forceinline__ XcdBarrier xcd_barrier_post(unsigned* bar, volatile LAS unsigned* st) {
    XcdBarrier b; b.bar = bar; b.x = xb_xcc_id(); b.st = st;
    if (threadIdx.x == 0) (void)xb_add(&bar[XB_XCNT(b.x)], 1u);
    return b;
}
__device__ __forceinline__ void xcd_barrier_complete(unsigned* bar, unsigned x, unsigned& nloc, unsigned& nx) {
    const unsigned G = gridDim.x * gridDim.y * gridDim.z;
    unsigned sum, cnt, mine, sp = 0u;
    for (;;) {
        sum = 0u; cnt = 0u; mine = 0u;
#pragma unroll 1
        for (unsigned j = 0; j < 16; ++j) { const unsigned c = xb_ld(&bar[XB_XCNT(j)]); sum += c; cnt += (c > 0u) ? 1u : 0u; mine = (j == x) ? c : mine; }
        if (sum == G) break;
        __builtin_amdgcn_s_sleep(1);
        if ((++sp & 255u) == 0u) { if (xb_ld(&bar[XB_TMO])) break; if (sp > XB_SPIN_CAP) { atomicAdd(&bar[XB_TMO], 1u); break; } }
    }
    nloc = mine > 0u ? mine : 1u; nx = cnt > 0u ? cnt : 1u;
}
__device__ __forceinline__ void xcd_barrier(const XcdBarrier& b) {
    asm volatile("s_waitcnt vmcnt(0)" ::: "memory");
    __syncthreads();
    if (threadIdx.x == 0) {
        unsigned* bar = b.bar;
        __builtin_amdgcn_s_waitcnt(0);
        unsigned nloc = b.st[0], nx = b.st[1];
        if (nloc == 0u) { xcd_barrier_complete(bar, b.x, nloc, nx); b.st[0] = nloc; b.st[1] = nx; }
        const unsigned old = xb_add(&bar[XB_XSUB(b.x)], 1u);
        const unsigned gen = old / nloc;
        if (old + 1u == (gen + 1u) * nloc) {
            __builtin_amdgcn_fence(__ATOMIC_RELEASE, "agent");
            asm volatile("s_waitcnt vmcnt(0)" ::: "memory");
            const unsigned og = xb_add(&bar[XB_TOP], 1u);
            const unsigned tg = og / nx;
            if (og + 1u == (tg + 1u) * nx) xb_add(&bar[XB_TOPGEN], 1u);
            else XB_SPIN(xb_ld(&bar[XB_TOPGEN]) == tg, bar);
            __builtin_amdgcn_fence(__ATOMIC_ACQUIRE, "agent");
            xb_add(&bar[XB_XGEN(b.x)], 1u);
            asm volatile("s_waitcnt vmcnt(0)" ::: "memory");
        } else {
            XB_SPIN(xb_ld(&bar[XB_XGEN(b.x)]) == gen, bar);
            __builtin_amdgcn_fence(__ATOMIC_ACQUIRE, "agent");
            asm volatile("s_waitcnt vmcnt(0)" ::: "memory");
        }
    }
    __syncthreads();
}

namespace pg8 {
constexpr int BM = 256, BK = 64, HALF = 128, HTB = HALF * BK * 2, STAGE_BYTES = 8 * HTB;
__host__ __device__ __forceinline__ int lds_byte(int r, int c) { const int st = (r >> 4) * 2 + (c >> 5), rr = r & 15, cc = c & 31, ob = rr * 64 + cc * 2; return st * 1024 + (ob ^ (((ob >> 9) & 1) << 5)); }
__host__ __device__ __forceinline__ void stage_rc(int b, int& R, int& C) { const int st = b / 1024, sb = b % 1024, swz = sb ^ (((sb >> 9) & 1) << 5); R = (st >> 1) * 16 + swz / 64; C = (st & 1) * 32 + (swz % 64) / 2; }
__host__ __device__ __forceinline__ int perm32(int rho) { const int n = rho >> 4, i = rho & 15; return 8 * (i >> 2) + 4 * n + (i & 3); }
__host__ __device__ __forceinline__ int perm32p(int rho) { const int n = rho >> 4, i = rho & 15, q = i >> 2; return 16 * (q & 1) + 2 * (4 * n + (i & 3)) + (q >> 1); }
struct EpiS1;
template <class E> struct PermKind { static constexpr int v = E::PERM ? 1 : 0; };
template <> struct PermKind<EpiS1> { static constexpr int v = 2; };

struct Unit { int pm, pn; const char* pa; const char* pb; long oo; long hb; int nt; };

__device__ __forceinline__ void tile_order(int L, int nM, int nN, int& pm, int& pn) {
    const int nwg = nM * nN; int wgid = L;
    { const int q = nwg / 8, r = nwg % 8, xcd = wgid % 8, off = wgid / 8; wgid = (xcd < r ? xcd * (q + 1) : r * (q + 1) + (xcd - r) * q) + off; }
    const int nig = 8 * nN, gid = wgid / nig, fm = gid * 8, gsz = (nM - fm) < 8 ? (nM - fm) : 8;
    pm = fm + ((wgid % nig) % gsz); pn = (wgid % nig) / gsz;
}

template <class Epi, class Sched, bool ALIGN_EPI>
__device__ __forceinline__ void gemm_phase(LAS unsigned char* lds, const int K, const int lda, const int ldb, const Sched& S, const Epi& E, const int G, const int c) {
    int tid_ = threadIdx.x; asm volatile("" : "+v"(tid_));
    const int tid = tid_, wid = __builtin_amdgcn_readfirstlane(tid >> 6), lane = tid & 63, wr = wid >> 2, wc = wid & 3, fr = lane & 15, fq = lane >> 4;
    const int nt_full = K / BK;
    int voffA[2], voffB[2], voffB1[2];
#pragma unroll
    for (int i = 0; i < 2; ++i) { int R, C; stage_rc(tid * 16 + i * 8192, R, C); const int Rb = PermKind<Epi>::v == 2 ? ((R & ~31) + perm32p(R & 31)) : PermKind<Epi>::v == 1 ? ((R & ~31) + perm32(R & 31)) : R;
        voffA[i] = (Sched::a_row(R) * lda + C) * 2; voffB[i] = (Rb * ldb + C) * 2; voffB1[i] = Sched::B_MIRROR ? (-Rb * ldb + C) * 2 : voffB[i]; }
    const size_t kstep = (size_t)(BK * 2);
    const size_t hstepA = (size_t)Sched::A_HROWS * lda * 2;
    const unsigned ldsw = (unsigned)wid * 1024u;
    const int aoff = lds_byte(wr * 64 + fr, fq * 8), boff = lds_byte(wc * 32 + fr, fq * 8);
#define PG8_SA(b, h) (((b) * 2 + (h)) * HTB)
#define PG8_SB(b, h) ((4 + (b) * 2 + (h)) * HTB)
#define PG8_STAGE(bufoff, gbase, voff) do { _Pragma("unroll") for (int _i = 0; _i < 2; ++_i) \
        __builtin_amdgcn_global_load_lds((const unsigned*)((const char*)(gbase) + (long)(voff)[_i]), (LAS unsigned*)(lds + (bufoff) + ldsw + _i * 8192), 16, 0, 0); } while (0)
#define PG8_LDA(dst, b, h) do { _Pragma("unroll") for (int m = 0; m < 4; ++m) _Pragma("unroll") for (int k = 0; k < 2; ++k) dst[m][k] = *(const LAS bf16x8*)(lds + PG8_SA(b, h) + aoff + m * 2048 + k * 1024); } while (0)
#define PG8_LDB(dst, b, h) do { _Pragma("unroll") for (int n = 0; n < 2; ++n) _Pragma("unroll") for (int k = 0; k < 2; ++k) dst[n][k] = *(const LAS bf16x8*)(lds + PG8_SB(b, h) + boff + n * 2048 + k * 1024); } while (0)
#define PG8_MMA(ai, bj, At, Bt) do { __builtin_amdgcn_s_setprio(1); _Pragma("unroll") for (int m = 0; m < 4; ++m) _Pragma("unroll") for (int n = 0; n < 2; ++n) _Pragma("unroll") for (int k = 0; k < 2; ++k) { \
        if constexpr (Epi::I8) acc[ai][bj][m][n] = __builtin_bit_cast(f32x4, __builtin_amdgcn_mfma_i32_16x16x64_i8(__builtin_bit_cast(i32x4, Bt[n][k]), __builtin_bit_cast(i32x4, At[m][k]), __builtin_bit_cast(i32x4, acc[ai][bj][m][n]), 0, 0, 0)); \
        else acc[ai][bj][m][n] = __builtin_amdgcn_mfma_f32_16x16x32_bf16(Bt[n][k], At[m][k], acc[ai][bj][m][n], 0, 0, 0); } __builtin_amdgcn_s_setprio(0); } while (0)
#define PG8_WAIT_V(n) asm volatile("s_waitcnt vmcnt(" #n ")" ::: "memory")
#define PG8_WAIT_L(n) asm volatile("s_waitcnt lgkmcnt(" #n ")" ::: "memory")
#define PG8_BAR __builtin_amdgcn_s_barrier()
#define PG8_SCHED __builtin_amdgcn_sched_barrier(0)
    Unit cur, nxt; int ui = 0;
    { const long L = S.unit(0, c, G); if (L >= S.total()) return; S.decode((int)L, cur); asm volatile("" : "+s"(cur.pa), "+s"(cur.pb)); }
    f32x4 acc[2][2][4][2];
#pragma unroll
    for (int a = 0; a < 2; ++a)
#pragma unroll
        for (int b = 0; b < 2; ++b)
#pragma unroll
            for (int m = 0; m < 4; ++m)
#pragma unroll
                for (int n = 0; n < 2; ++n) acc[a][b][m][n] = (f32x4){0.f, 0.f, 0.f, 0.f};
    bf16x8 At[4][2], B0[2][2], B1[2][2];
    const char* cA = cur.pa; const char* cB = cur.pb;
    long cHB = cur.hb;
    PG8_STAGE(PG8_SB(0, 0), cB, voffB); PG8_STAGE(PG8_SB(0, 1), cB + cHB, voffB1); PG8_STAGE(PG8_SA(0, 0), cA, voffA); PG8_STAGE(PG8_SA(0, 1), cA + hstepA, voffA);
    if (wr == 1) PG8_BAR;
    PG8_WAIT_V(2); PG8_BAR;
    PG8_STAGE(PG8_SB(1, 0), cB + kstep, voffB); PG8_STAGE(PG8_SA(1, 0), cA + kstep, voffA); PG8_STAGE(PG8_SB(1, 1), cB + cHB + kstep, voffB1);
    PG8_WAIT_V(6); PG8_BAR;
    for (;;) {
        bool has_next; { const long L = S.unit(ui + 1, c, G); has_next = L < S.total(); if (has_next) { S.decode((int)L, nxt); asm volatile("" : "+s"(nxt.pa), "+s"(nxt.pb)); } }
        const char* nA = has_next ? nxt.pa : cA; const char* nB = has_next ? nxt.pb : cB; const long nHB = has_next ? nxt.hb : cHB;
        const int nt = Sched::SPLITK ? cur.nt : nt_full;
#pragma clang loop unroll(disable)
        for (int t = 0; t < nt; t += 2) {
            const bool last = (t == nt - 2);
            const char* a1 = cA + (size_t)(t + 1) * kstep;
            const char* a2 = last ? nA : cA + (size_t)(t + 2) * kstep; const char* b2 = last ? nB : cB + (size_t)(t + 2) * kstep;
            const char* a3 = a2 + kstep; const char* b3 = b2 + kstep; const long hB2 = last ? nHB : cHB;
            if constexpr (Epi::HOOK_TILES > 0) { if (t != 0 && (t % Epi::HOOK_TILES) == 0) E.hook(acc, cur, t / Epi::HOOK_TILES, wr, wc, fr, fq); }
            PG8_LDB(B0, 0, 0); PG8_LDB(B1, 0, 1); PG8_SCHED; PG8_LDA(At, 0, 0); PG8_STAGE(PG8_SA(1, 1), a1 + hstepA, voffA);
            PG8_WAIT_V(8); PG8_WAIT_L(0); PG8_BAR; PG8_MMA(0, 0, At, B0); PG8_MMA(0, 1, At, B1); PG8_BAR; PG8_SCHED;
            PG8_LDA(At, 0, 1); PG8_STAGE(PG8_SB(0, 0), b2, voffB); PG8_STAGE(PG8_SB(0, 1), b2 + hB2, voffB1); PG8_STAGE(PG8_SA(0, 0), a2, voffA);
            PG8_WAIT_V(8); PG8_WAIT_L(0); PG8_BAR; PG8_MMA(1, 0, At, B0); PG8_MMA(1, 1, At, B1); PG8_BAR; PG8_SCHED;
            PG8_LDB(B0, 1, 0); PG8_LDB(B1, 1, 1); PG8_SCHED; PG8_LDA(At, 1, 0); PG8_STAGE(PG8_SA(0, 1), a2 + hstepA, voffA);
            PG8_WAIT_V(8); PG8_WAIT_L(0); PG8_BAR; PG8_MMA(0, 0, At, B0); PG8_MMA(0, 1, At, B1); PG8_BAR; PG8_SCHED;
            PG8_LDA(At, 1, 1); PG8_STAGE(PG8_SB(1, 0), b3, voffB); PG8_STAGE(PG8_SB(1, 1), b3 + hB2, voffB1); PG8_STAGE(PG8_SA(1, 0), a3, voffA);
            PG8_WAIT_V(8); PG8_WAIT_L(0); PG8_BAR; PG8_MMA(1, 0, At, B0); PG8_MMA(1, 1, At, B1); PG8_BAR; PG8_SCHED;
        }
        if constexpr (ALIGN_EPI) { if (wr == 0) PG8_BAR; }
        E(acc, cur, wr, wc, fr, fq);
        if (!has_next) break;
#pragma unroll
        for (int a = 0; a < 2; ++a)
#pragma unroll
            for (int b = 0; b < 2; ++b)
#pragma unroll
                for (int m = 0; m < 4; ++m)
#pragma unroll
                    for (int n = 0; n < 2; ++n) acc[a][b][m][n] = (f32x4){0.f, 0.f, 0.f, 0.f};
        cur = nxt; cA = nA; cB = nB; cHB = nHB; ++ui;
        if constexpr (ALIGN_EPI) { if (wr == 1) PG8_BAR; }
    }
    PG8_WAIT_V(0);
    if constexpr (!ALIGN_EPI) { if (wr == 0) PG8_BAR; }
    PG8_BAR;
#undef PG8_SA
#undef PG8_SB
#undef PG8_STAGE
#undef PG8_LDA
#undef PG8_LDB
#undef PG8_MMA
#undef PG8_WAIT_V
#undef PG8_WAIT_L
#undef PG8_BAR
#undef PG8_SCHED
}

struct SchedRect {
    const char* A; const char* B; int nM, nN; size_t aS, bS; int extra; int t_c0, t_g;
    static __device__ __forceinline__ int a_row(int R) { return R; }
    static constexpr int A_HROWS = 128; static constexpr bool B_MIRROR = false; static constexpr bool SPLITK = false;
    __device__ __forceinline__ int total() const { return nM * nN + extra; }
    __device__ __forceinline__ long unit(int ui, int c, int G) const {
        if (t_g == 0) return (long)ui * G + c;
        const int tot = nM * nN + extra, full = tot / G;
        if (ui < full) return (long)ui * G + c;
        const int cc = c - t_c0; if (cc < 0 || cc >= t_g) return tot;
        return (long)full * G + (long)(ui - full) * t_g + cc;
    }
    __device__ __forceinline__ void decode(int L, Unit& u) const {
        const int nr = nM * nN;
        if (L < nr) tile_order(L, nM, nN, u.pm, u.pn);
        else { const int e = L - nr; u.pm = nM + e / 10; const int q = e % 10; u.pn = q < 2 ? 4 + q : 8 + q; }
        u.pa = A + (size_t)u.pm * aS; u.pb = B + (size_t)u.pn * bS; u.oo = 0; u.hb = (long)(bS >> 1);
    }
};
struct SchedUp {
    const char* A; const char* B; int nM, nN; size_t aS, bS;
    static __device__ __forceinline__ int a_row(int R) { return 126 * (R >> 6) + (R & 63); }
    static constexpr int A_HROWS = 64; static constexpr bool B_MIRROR = false; static constexpr bool SPLITK = false;
    __device__ __forceinline__ int total() const { return nM * nN; }
    __device__ __forceinline__ long unit(int ui, int c, int G) const { return (long)ui * G + c; }
    __device__ __forceinline__ void decode(int L, Unit& u) const { tile_order(L, nM, nN, u.pm, u.pn); u.pa = A + (size_t)u.pm * aS; u.pb = B + (size_t)u.pn * bS; u.oo = 0; u.hb = (long)(bS >> 1); }
};
struct SchedJob {
    const char* A; const char* B; int nZ2, nM, nN, nTot; long hbB;
    size_t az1, az2, am, bz1, bz2, bn;
    long oz1, oz2, om, on;
    static __device__ __forceinline__ int a_row(int R) { return R; }
    static constexpr int A_HROWS = 128; static constexpr bool B_MIRROR = false; static constexpr bool SPLITK = false;
    __device__ __forceinline__ int total() const { return nTot; }
    __device__ __forceinline__ long unit(int ui, int c, int G) const { return (long)ui * G + c; }
    __device__ __forceinline__ void decode(int L, Unit& u) const {
        const int per = nM * nN, z = L / per, rem = L - z * per, z1 = z / nZ2, z2 = z - z1 * nZ2;
        tile_order(rem, nM, nN, u.pm, u.pn);
        u.pa = A + (size_t)z1 * az1 + (size_t)z2 * az2 + (size_t)u.pm * am; u.pb = B + (size_t)z1 * bz1 + (size_t)z2 * bz2 + (size_t)u.pn * bn;
        u.oo = (long)z1 * oz1 + (long)z2 * oz2 + (long)u.pm * om + (long)u.pn * on; u.hb = hbB;
    }
};

struct SchedSplit {
    const char* A; const char* B; size_t aS, bS; int pairs, nctx;
    static __device__ __forceinline__ int a_row(int R) { return R; }
    static constexpr int A_HROWS = 128; static constexpr bool B_MIRROR = false; static constexpr bool SPLITK = true;
    __device__ __forceinline__ int total() const { return 1024 + nctx; }
    __device__ __forceinline__ long unit(int ui, int c, int G) const { return (long)ui * G + c; }
    __device__ __forceinline__ void decode(int L, Unit& u) const {
        if (L < 1024) { tile_order(L, 64, 16, u.pm, u.pn); u.pa = A + (size_t)u.pm * aS; u.pb = B + (size_t)u.pn * bS; u.nt = 2 * pairs; u.oo = 0; }
        else { const int e = L - 1024, tile = e >> 3, p = e & 7; u.pm = 64 + (tile >> 4); u.pn = tile & 15;
            const int q = pairs >> 3, r = pairs & 7;
            const int start = p * q + (p < r ? p : r), len = q + (p < r ? 1 : 0);
            u.pa = A + (size_t)u.pm * aS + (size_t)start * 256; u.pb = B + (size_t)u.pn * bS + (size_t)start * 256; u.nt = 2 * len; u.oo = 1 + p; }
        u.hb = (long)(bS >> 1);
    }
};
struct SchedV {
    const char* A; const char* B; int nM;
    static __device__ __forceinline__ int a_row(int R) { return R; }
    static constexpr int A_HROWS = 128; static constexpr bool B_MIRROR = false; static constexpr bool SPLITK = false;
    __device__ __forceinline__ int total() const { return nM * 43; }
    __device__ __forceinline__ long unit(int ui, int c, int G) const { return (long)ui * G + c; }
    __device__ __forceinline__ void decode(int L, Unit& u) const { tile_order(L, nM, 43, u.pm, u.pn);
        u.pa = A + (size_t)u.pm * 256 * DM * 2; u.pb = B + (size_t)(u.pn * 512 + 128) * DM * 2; u.hb = (long)256 * DM * 2; u.oo = 0; }
};
constexpr int ZK = 8320;
struct SchedS1 {
    const char* A; const char* Ub;
    static __device__ __forceinline__ int a_row(int R) { return R; }
    static constexpr int A_HROWS = 128; static constexpr bool B_MIRROR = true; static constexpr bool SPLITK = false;
    __device__ __forceinline__ int total() const { return 8 * 64; }
    __device__ __forceinline__ long unit(int ui, int c, int G) const { return (long)ui * G + c; }
    __device__ __forceinline__ void decode(int L, Unit& u) const {
        const int z = L >> 6, r = L & 63, part = r >> 5, tile = r & 31, n0 = tile * 128, b = z >> 2, g = z & 3;
        u.pm = part; u.pn = tile;
        u.pa = A + (size_t)part * 256 * 256 * 2;
        u.pb = Ub + ((size_t)(b * SEQ + n0) * ACTW + g * 256) * 2;
        u.hb = (long)(SEQ - 2 * n0) * ACTW * 2;
        u.oo = (long)z * 256 * ZK + (part ? 4096 : 0) + n0 / 2;
    }
};
struct SchedDft {
    const char* A; const char* B;
    static __device__ __forceinline__ int a_row(int R) { return R; }
    static constexpr int A_HROWS = 128; static constexpr bool B_MIRROR = false; static constexpr bool SPLITK = true;
    __device__ __forceinline__ int total() const { return 256; }
    __device__ __forceinline__ long unit(int ui, int c, int G) const { return (long)ui * G + c; }
    __device__ __forceinline__ void decode(int L, Unit& u) const {
        const int xcd = L & 7, i = L >> 3, part = xcd >> 1, z = (xcd & 1) * 4 + (i >> 3), tile = i & 7;
        u.pm = tile; u.pn = part;
        u.pa = A + ((size_t)(1 + 256 * tile) * ZK + part * 2048) * 2;
        u.pb = B + ((size_t)z * 256 * ZK + part * 2048) * 2;
        u.hb = 128L * ZK * 2; u.nt = 32; u.oo = ((long)(part * 8 + z) * 2048 + 256 * tile) * 256;
    }
};
struct EpiF32 {
    static constexpr bool PERM = true; static constexpr int HOOK_TILES = 0; static constexpr bool I8 = false;
    float* O;
    __device__ __forceinline__ void hook(f32x4 (&)[2][2][4][2], const Unit&, int, int, int, int, int) const {}
    __device__ __forceinline__ void operator()(const f32x4 (&acc)[2][2][4][2], const Unit& u, int wr, int wc, int fr, int fq) const {
        float* base = O + u.oo + wc * 32 + 8 * fq;
#pragma unroll
        for (int ai = 0; ai < 2; ++ai)
#pragma unroll
            for (int m = 0; m < 4; ++m) { float* rowp = base + (size_t)(ai * HALF + wr * 64 + m * 16 + fr) * 256;
#pragma unroll
                for (int bj = 0; bj < 2; ++bj) { *(f32x4*)(rowp + bj * HALF) = acc[ai][bj][m][0]; *(f32x4*)(rowp + bj * HALF + 4) = acc[ai][bj][m][1]; } }
    }
};
struct EpiStore {
    static constexpr bool PERM = true; static constexpr int HOOK_TILES = 0; static constexpr bool I8 = false;
    bf16* O; int ldc;
    __device__ __forceinline__ void hook(f32x4 (&)[2][2][4][2], const Unit&, int, int, int, int, int) const {}
    __device__ __forceinline__ void operator()(const f32x4 (&acc)[2][2][4][2], const Unit& u, int wr, int wc, int fr, int fq) const {
        bf16* base = O + u.oo + wc * 32 + 8 * fq;
#pragma unroll
        for (int ai = 0; ai < 2; ++ai)
#pragma unroll
            for (int m = 0; m < 4; ++m) { bf16* rowp = base + (size_t)(ai * HALF + wr * 64 + m * 16 + fr) * ldc;
#pragma unroll
                for (int bj = 0; bj < 2; ++bj) { const f32x4 v0 = acc[ai][bj][m][0], v1 = acc[ai][bj][m][1];
                    u32x4 w; w.x = cvt_pk_bf16(v0[0], v0[1]); w.y = cvt_pk_bf16(v0[2], v0[3]); w.z = cvt_pk_bf16(v1[0], v1[1]); w.w = cvt_pk_bf16(v1[2], v1[3]);
                    *(u32x4*)(rowp + bj * HALF) = w; } }
    }
};

struct EpiS1 {
    static constexpr bool PERM = true; static constexpr int HOOK_TILES = 0; static constexpr bool I8 = false;
    bf16* O;
    __device__ __forceinline__ void hook(f32x4 (&)[2][2][4][2], const Unit&, int, int, int, int, int) const {}
    __device__ __forceinline__ void operator()(const f32x4 (&acc)[2][2][4][2], const Unit& u, int wr, int wc, int fr, int fq) const {
        const float sg = u.pm ? -1.0f : 1.0f;
        const bool self0 = (u.pm == 0) && (wc == 0) && (fq == 0) && (u.pn == 0);
        bf16* base = O + u.oo + wc * 16 + 8 * (fq & 1) + ((fq >> 1) ? 2048 : 0);
#pragma unroll
        for (int ai = 0; ai < 2; ++ai)
#pragma unroll
            for (int m = 0; m < 4; ++m) { f32x4 v0 = acc[ai][0][m][0] + sg * acc[ai][1][m][0]; const f32x4 v1 = acc[ai][0][m][1] + sg * acc[ai][1][m][1];
                if (self0) v0[0] = acc[ai][0][m][0][0];
                u32x4 w; w.x = cvt_pk_bf16(v0[0], v0[1]); w.y = cvt_pk_bf16(v0[2], v0[3]); w.z = cvt_pk_bf16(v1[0], v1[1]); w.w = cvt_pk_bf16(v1[2], v1[3]);
                *(u32x4*)(base + (size_t)(ai * HALF + wr * 64 + m * 16 + fr) * ZK) = w; }
    }
};

struct EpiIn {
    static constexpr bool PERM = true; static constexpr int HOOK_TILES = 0; static constexpr bool I8 = false;
    bf16* ACT; bf16* Gt; const float* rope;
    __device__ __forceinline__ void hook(f32x4 (&)[2][2][4][2], const Unit&, int, int, int, int, int) const {}
    __device__ __forceinline__ void operator()(const f32x4 (&acc)[2][2][4][2], const Unit& u, int wr, int wc, int fr, int fq) const {
        const int pn = u.pn;
        const int colw = wc * 32 + 8 * fq;
        if (pn >= 26) {
            const int gi = (pn - 26) >> 4, gpn = (pn - 26) & 15;
            bf16* base = Gt + ((size_t)((gi * 66 + u.pm) * 16 + gpn) * 16 * 8 + (wr * 4 + wc)) * 512 + (size_t)(fq * 16 + fr) * 8;
#pragma unroll
            for (int ai = 0; ai < 2; ++ai)
#pragma unroll
                for (int m = 0; m < 4; ++m)
#pragma unroll
                    for (int bj = 0; bj < 2; ++bj) { const f32x4 v0 = acc[ai][bj][m][0], v1 = acc[ai][bj][m][1];
                        u32x4 w; w.x = cvt_pk_bf16(sigmoidf_(v0[0]), sigmoidf_(v0[1])); w.y = cvt_pk_bf16(sigmoidf_(v0[2]), sigmoidf_(v0[3]));
                        w.z = cvt_pk_bf16(sigmoidf_(v1[0]), sigmoidf_(v1[1])); w.w = cvt_pk_bf16(sigmoidf_(v1[2]), sigmoidf_(v1[3]));
                        *(u32x4*)(base + (size_t)((ai * 4 + m) * 2 + bj) * 4096) = w; }
            return;
        }
        const bool do_rope = pn <= 4;
        const float qs = (pn < 4 || (pn >= 6 && pn < 10)) ? QSCALE : 1.0f;
        bf16* base = ACT + (size_t)pn * 256 + colw;
        const int hf = wc >> 1, i0 = 16 * (wc & 1) + 4 * fq;
        f32x4 csa[8], csb[8];
#pragma unroll
        for (int k = 0; k < 8; ++k) { csa[k] = (f32x4){1.f, 0.f, 1.f, 0.f}; csb[k] = csa[k]; const int row = u.pm * BM + (k >> 2) * HALF + wr * 64 + (k & 3) * 16 + fr;
            if (do_rope && row < TL) { const int t = row & (SEQ - 1), pos = hf ? (t & 63) : (t >> 6); const f32x4* rp = (const f32x4*)(rope + (size_t)(pos * 32 + i0) * 2); csa[k] = rp[0]; csb[k] = rp[1]; } }
#pragma unroll
        for (int ai = 0; ai < 2; ++ai)
#pragma unroll
            for (int m = 0; m < 4; ++m) { const int row = u.pm * BM + ai * HALF + wr * 64 + m * 16 + fr; bf16* rowp = base + (size_t)row * ACTW;
                const f32x4 cs0 = csa[ai * 4 + m], cs1 = csb[ai * 4 + m];
#pragma unroll
                for (int bj = 0; bj < 2; ++bj) { f32x4 v0 = acc[ai][bj][m][0] * qs, v1 = acc[ai][bj][m][1] * qs;
                    if (do_rope) { f32x4 y0, y1;
                        y0[0] = v0[0] * cs0[0] - v0[1] * cs0[1]; y0[1] = v0[0] * cs0[1] + v0[1] * cs0[0]; y0[2] = v0[2] * cs0[2] - v0[3] * cs0[3]; y0[3] = v0[2] * cs0[3] + v0[3] * cs0[2];
                        y1[0] = v1[0] * cs1[0] - v1[1] * cs1[1]; y1[1] = v1[0] * cs1[1] + v1[1] * cs1[0]; y1[2] = v1[2] * cs1[2] - v1[3] * cs1[3]; y1[3] = v1[2] * cs1[3] + v1[3] * cs1[2];
                        v0 = y0; v1 = y1; }
                    u32x4 w; w.x = cvt_pk_bf16(v0[0], v0[1]); w.y = cvt_pk_bf16(v0[2], v0[3]); w.z = cvt_pk_bf16(v1[0], v1[1]); w.w = cvt_pk_bf16(v1[2], v1[3]);
                    *(u32x4*)(rowp + bj * HALF) = w; } }
    }
};

struct EpiGate {
    static constexpr bool PERM = true; static constexpr int HOOK_TILES = 0; static constexpr bool I8 = true;
    bf16* Gt; const float* SH; const float* SW;
    __device__ __forceinline__ void hook(f32x4 (&)[2][2][4][2], const Unit&, int, int, int, int, int) const {}
    __device__ __forceinline__ void operator()(const f32x4 (&acc)[2][2][4][2], const Unit& u, int wr, int wc, int fr, int fq) const {
        const int gi = u.pn >> 4, gpn = u.pn & 15;
        float shr[8]; f32x4 swc[2][2];
#pragma unroll
        for (int k = 0; k < 8; ++k) shr[k] = SH[u.pm * BM + (k >> 2) * HALF + wr * 64 + (k & 3) * 16 + fr];
#pragma unroll
        for (int bj = 0; bj < 2; ++bj)
#pragma unroll
            for (int n = 0; n < 2; ++n) swc[bj][n] = *(const f32x4*)(SW + u.pn * BM + bj * HALF + wc * 32 + 8 * fq + 4 * n) * (-LOG2E);
        bf16* base = Gt + ((size_t)((gi * 66 + u.pm) * 16 + gpn) * 16 * 8 + (wr * 4 + wc)) * 512 + (size_t)(fq * 16 + fr) * 8;
#pragma unroll
        for (int ai = 0; ai < 2; ++ai)
#pragma unroll
            for (int m = 0; m < 4; ++m)
#pragma unroll
                for (int bj = 0; bj < 2; ++bj) { const i32x4 a0 = __builtin_bit_cast(i32x4, acc[ai][bj][m][0]), a1 = __builtin_bit_cast(i32x4, acc[ai][bj][m][1]); const float rs = shr[ai * 4 + m];
                    f32x4 v0, v1;
#pragma unroll
                    for (int j = 0; j < 4; ++j) { v0[j] = (float)a0[j] * rs * swc[bj][0][j]; v1[j] = (float)a1[j] * rs * swc[bj][1][j]; }
#define SG2(x) fast_rcp(1.0f + fast_exp2(x))
                    u32x4 w; w.x = cvt_pk_bf16(SG2(v0[0]), SG2(v0[1])); w.y = cvt_pk_bf16(SG2(v0[2]), SG2(v0[3]));
                    w.z = cvt_pk_bf16(SG2(v1[0]), SG2(v1[1])); w.w = cvt_pk_bf16(SG2(v1[2]), SG2(v1[3]));
#undef SG2
                    *(u32x4*)(base + (size_t)((ai * 4 + m) * 2 + bj) * 4096) = w; }
    }
};

struct EpiMerge {
    static constexpr bool PERM = true; static constexpr int HOOK_TILES = 16; static constexpr bool I8 = false;
    const bf16* Gt; bf16* MG; float* slab;
    static __device__ __forceinline__ float clampg(float s) { return fmaxf(s, 1e-9f); }
    __device__ __forceinline__ void hook(f32x4 (&acc)[2][2][4][2], const Unit& u, int j1, int wr, int wc, int fr, int fq) const {
        asm volatile("" : "+v"(fr), "+v"(fq));
        const bf16* g0 = Gt + ((size_t)(((j1 - 1) * 66 + u.pm) * 16 + u.pn) * 16 * 8 + (wr * 4 + wc)) * 512 + (size_t)(fq * 16 + fr) * 8;
        const bf16* g1 = g0 + (size_t)66 * 16 * 16 * 8 * 512;
#pragma unroll
        for (int ai = 0; ai < 2; ++ai) {
            u32x4 ga[4][2], gb[4][2];
#pragma unroll
            for (int m = 0; m < 4; ++m)
#pragma unroll
                for (int bj = 0; bj < 2; ++bj) { const size_t go = (size_t)((ai * 4 + m) * 2 + bj) * 4096; ga[m][bj] = *(const u32x4*)(g0 + go); gb[m][bj] = *(const u32x4*)(g1 + go); }
            asm volatile("s_waitcnt vmcnt(0)" ::: "memory");
#pragma unroll
            for (int m = 0; m < 4; ++m)
#pragma unroll
                for (int bj = 0; bj < 2; ++bj) { const u32x4 a = ga[m][bj], b = gb[m][bj];
                    f32x4 r0, r1;
                    r0[0] = clampg(bflo(a.x)) * fast_rcp(clampg(bflo(b.x))); r0[1] = clampg(bfhi(a.x)) * fast_rcp(clampg(bfhi(b.x)));
                    r0[2] = clampg(bflo(a.y)) * fast_rcp(clampg(bflo(b.y))); r0[3] = clampg(bfhi(a.y)) * fast_rcp(clampg(bfhi(b.y)));
                    r1[0] = clampg(bflo(a.z)) * fast_rcp(clampg(bflo(b.z))); r1[1] = clampg(bfhi(a.z)) * fast_rcp(clampg(bfhi(b.z)));
                    r1[2] = clampg(bflo(a.w)) * fast_rcp(clampg(bflo(b.w))); r1[3] = clampg(bfhi(a.w)) * fast_rcp(clampg(bfhi(b.w)));
                    acc[ai][bj][m][0] *= r0; acc[ai][bj][m][1] *= r1; }
            asm volatile("" ::: "memory");
        }
    }
    __device__ __forceinline__ void operator()(const f32x4 (&acc)[2][2][4][2], const Unit& u, int wr, int wc, int fr, int fq) const {
        const size_t cofs = (size_t)u.pn * 256 + wc * 32 + 8 * fq;
        if (u.oo >= 1) {
            const int p = (int)u.oo - 1;
            const bf16* gi = Gt + ((size_t)(((p >> 1) * 66 + u.pm) * 16 + u.pn) * 16 * 8 + (wr * 4 + wc)) * 512 + (size_t)(fq * 16 + fr) * 8;
            float* sl = slab + (size_t)p * TC * DM + cofs;
#pragma unroll
            for (int ai = 0; ai < 2; ++ai) {
                u32x4 ga[4][2];
#pragma unroll
                for (int m = 0; m < 4; ++m)
#pragma unroll
                    for (int bj = 0; bj < 2; ++bj) ga[m][bj] = *(const u32x4*)(gi + (size_t)((ai * 4 + m) * 2 + bj) * 4096);
#pragma unroll
                for (int m = 0; m < 4; ++m) { const size_t row = (size_t)(u.pm * BM + ai * HALF + wr * 64 + m * 16 + fr - TL);
#pragma unroll
                    for (int bj = 0; bj < 2; ++bj) { const u32x4 a = ga[m][bj]; const f32x4 v0 = acc[ai][bj][m][0], v1 = acc[ai][bj][m][1];
                        const f32x4 o0 = {v0[0] * clampg(bflo(a.x)), v0[1] * clampg(bfhi(a.x)), v0[2] * clampg(bflo(a.y)), v0[3] * clampg(bfhi(a.y))};
                        const f32x4 o1 = {v1[0] * clampg(bflo(a.z)), v1[1] * clampg(bfhi(a.z)), v1[2] * clampg(bflo(a.w)), v1[3] * clampg(bfhi(a.w))};
                        *(f32x4*)(sl + row * DM + bj * HALF) = o0; *(f32x4*)(sl + row * DM + bj * HALF + 4) = o1; } } }
            return;
        }
        const bf16* g3 = Gt + ((size_t)((3 * 66 + u.pm) * 16 + u.pn) * 16 * 8 + (wr * 4 + wc)) * 512 + (size_t)(fq * 16 + fr) * 8;
#pragma unroll
        for (int ai = 0; ai < 2; ++ai) {
            u32x4 ga[4][2];
#pragma unroll
            for (int m = 0; m < 4; ++m)
#pragma unroll
                for (int bj = 0; bj < 2; ++bj) ga[m][bj] = *(const u32x4*)(g3 + (size_t)((ai * 4 + m) * 2 + bj) * 4096);
#pragma unroll
            for (int m = 0; m < 4; ++m) { const size_t row = (size_t)(u.pm * BM + ai * HALF + wr * 64 + m * 16 + fr);
#pragma unroll
                for (int bj = 0; bj < 2; ++bj) { const u32x4 a = ga[m][bj]; const f32x4 v0 = acc[ai][bj][m][0], v1 = acc[ai][bj][m][1];
                    u32x4 w; w.x = cvt_pk_bf16(v0[0] * clampg(bflo(a.x)), v0[1] * clampg(bfhi(a.x))); w.y = cvt_pk_bf16(v0[2] * clampg(bflo(a.y)), v0[3] * clampg(bfhi(a.y)));
                    w.z = cvt_pk_bf16(v1[0] * clampg(bflo(a.z)), v1[1] * clampg(bfhi(a.z))); w.w = cvt_pk_bf16(v1[2] * clampg(bflo(a.w)), v1[3] * clampg(bfhi(a.w)));
                    *(u32x4*)(MG + row * DM + cofs + bj * HALF) = w; } }
            asm volatile("" ::: "memory");
        }
    }
};

struct EpiResid {
    static constexpr bool PERM = false; static constexpr int HOOK_TILES = 0; static constexpr bool I8 = false;
    const float* r_lat; const float* r_ctx; float* X; const float* gt; float* slab;
    __device__ __forceinline__ void hook(f32x4 (&)[2][2][4][2], const Unit&, int, int, int, int, int) const {}
    __device__ __forceinline__ void operator()(const f32x4 (&acc)[2][2][4][2], const Unit& u, int wr, int wc, int fr, int fq) const {
        const int var = u.pm < 32 ? 0 : (u.pm < 64 ? 1 : 2);
        const int col0 = u.pn * BM + wc * 32 + 4 * fq;
        const float* gv = gt + (size_t)var * MODW + col0;
        f32x4 gg[2][2];
#pragma unroll
        for (int bj = 0; bj < 2; ++bj)
#pragma unroll
            for (int n = 0; n < 2; ++n) gg[bj][n] = *(const f32x4*)(gv + bj * HALF + n * 16);
        if (u.oo >= 1) {
            float* sl = slab + (size_t)(u.oo - 1) * TC * DM;
#pragma unroll
            for (int ai = 0; ai < 2; ++ai)
#pragma unroll
                for (int m = 0; m < 4; ++m) { const int row = u.pm * BM + ai * HALF + wr * 64 + m * 16 + fr - TL; float* xp = sl + (size_t)row * DM + col0;
#pragma unroll
                    for (int bj = 0; bj < 2; ++bj)
#pragma unroll
                        for (int n = 0; n < 2; ++n) *(f32x4*)(xp + bj * HALF + n * 16) = gg[bj][n] * acc[ai][bj][m][n]; }
            return;
        }
#pragma unroll
        for (int ai = 0; ai < 2; ++ai) {
            f32x4 rr[4][2][2];
#pragma unroll
            for (int m = 0; m < 4; ++m) { const int row = u.pm * BM + ai * HALF + wr * 64 + m * 16 + fr;
                const float* rp = (row < TL ? r_lat + (size_t)row * DM : r_ctx + (size_t)(row - TL) * DM) + col0;
#pragma unroll
                for (int bj = 0; bj < 2; ++bj)
#pragma unroll
                    for (int n = 0; n < 2; ++n) rr[m][bj][n] = *(const f32x4*)(rp + bj * HALF + n * 16); }
#pragma unroll
            for (int m = 0; m < 4; ++m) { const int row = u.pm * BM + ai * HALF + wr * 64 + m * 16 + fr; float* xp = X + (size_t)row * DM + col0;
#pragma unroll
                for (int bj = 0; bj < 2; ++bj)
#pragma unroll
                    for (int n = 0; n < 2; ++n) *(f32x4*)(xp + bj * HALF + n * 16) = rr[m][bj][n] + gg[bj][n] * acc[ai][bj][m][n]; }
            asm volatile("" ::: "memory");
        }
    }
};

__device__ __forceinline__ float dpp_ror1(float x) { return __builtin_bit_cast(float, __builtin_amdgcn_update_dpp(0, __builtin_bit_cast(int, x), 0x121, 0xF, 0xF, false)); }
__device__ __forceinline__ float dpp_ror15(float x) { return __builtin_bit_cast(float, __builtin_amdgcn_update_dpp(0, __builtin_bit_cast(int, x), 0x12F, 0xF, 0xF, false)); }
struct EpiA8 {
    static constexpr bool PERM = true; static constexpr int HOOK_TILES = 0; static constexpr bool I8 = true;
    bf16* U; const float* cw; const float* cb; const float* SH; const float* SW;
    __device__ __forceinline__ void hook(f32x4 (&)[2][2][4][2], const Unit&, int, int, int, int, int) const {}
    __device__ __forceinline__ void operator()(const f32x4 (&acc)[2][2][4][2], const Unit& u, int wr, int wc, int fr, int fq) const {
        const int Rbase = 252 * u.pm - 1 + 126 * wr;
        float shr[8];
#pragma unroll
        for (int k = 0; k < 8; ++k) { const int R = Rbase + 16 * k + fr; shr[k] = SH[min(max(R, 0), T - 1)]; }
        int lfr = fr;
#pragma unroll
        for (int bj = 0; bj < 2; ++bj) {
            asm volatile("" : "+v"(lfr));
            const int ch0 = u.pn * 256 + bj * 128 + wc * 32 + 8 * fq;
            float w0[8], w1[8], w2[8], bb[8], sw[8];
            { const f32x4 a0 = *(const f32x4*)(cw + ch0), a1 = *(const f32x4*)(cw + ch0 + 4), b0 = *(const f32x4*)(cw + DFF + ch0), b1 = *(const f32x4*)(cw + DFF + ch0 + 4);
              const f32x4 c0 = *(const f32x4*)(cw + 2 * DFF + ch0), c1 = *(const f32x4*)(cw + 2 * DFF + ch0 + 4), d0 = *(const f32x4*)(cb + ch0), d1 = *(const f32x4*)(cb + ch0 + 4);
              const f32x4 e0 = *(const f32x4*)(SW + ch0), e1 = *(const f32x4*)(SW + ch0 + 4);
#pragma unroll
              for (int q = 0; q < 4; ++q) { w0[q] = a0[q]; w0[4 + q] = a1[q]; w1[q] = b0[q]; w1[4 + q] = b1[q]; w2[q] = c0[q]; w2[4 + q] = c1[q]; bb[q] = d0[q]; bb[4 + q] = d1[q]; sw[q] = e0[q]; sw[4 + q] = e1[q]; } }
#define A8G(k, cc) ((float)__builtin_bit_cast(i32x4, acc[(k) >> 2][bj][(k) & 3][(cc) >> 2])[(cc) & 3] * shr[k] * sw[cc])
            float spp[8], spc[8], snc[8], snn[8], gcur[8], gnx[8];
#pragma unroll
            for (int cc = 0; cc < 8; ++cc) { spp[cc] = 0.f; gcur[cc] = A8G(0, cc); spc[cc] = dpp_ror1(gcur[cc]); snc[cc] = dpp_ror15(gcur[cc]); }
#pragma unroll
            for (int k = 0; k < 8; ++k) {
                asm volatile("" : "+v"(lfr));
                if (k < 7) {
#pragma unroll
                    for (int cc = 0; cc < 8; ++cc) { gnx[cc] = A8G(k + 1, cc); snn[cc] = dpp_ror15(gnx[cc]); }
                } else {
#pragma unroll
                    for (int cc = 0; cc < 8; ++cc) { gnx[cc] = 0.f; snn[cc] = 0.f; }
                }
                const int y = 16 * k + lfr, R = Rbase + y;
                const bool fst = (R < TL) ? ((R & (SEQ - 1)) == 0) : ((R & 255) == 0), lst = (R < TL) ? ((R & (SEQ - 1)) == SEQ - 1) : ((R & 255) == 255);
                float res[8];
#pragma unroll
                for (int cc = 0; cc < 8; ++cc) {
                    float P = (lfr > 0) ? spc[cc] : spp[cc], N = (lfr < 15) ? snc[cc] : snn[cc];
                    P = fst ? 0.f : P; N = lst ? 0.f : N;
                    const float a = w0[cc] * P + w1[cc] * gcur[cc] + w2[cc] * N + bb[cc];
                    res[cc] = a * sigmoidf_(a);
                }
                if (y >= 1 && y <= 126 && R < T) { u32x4 w; w.x = cvt_pk_bf16(res[0], res[1]); w.y = cvt_pk_bf16(res[2], res[3]); w.z = cvt_pk_bf16(res[4], res[5]); w.w = cvt_pk_bf16(res[6], res[7]);
                    *(u32x4*)(U + (size_t)R * DFF + ch0) = w; }
                if (k < 7) {
#pragma unroll
                    for (int cc = 0; cc < 8; ++cc) { spp[cc] = spc[cc]; gcur[cc] = gnx[cc]; spc[cc] = dpp_ror1(gnx[cc]); snc[cc] = snn[cc]; }
                }
            }
#undef A8G
        }
    }
};
struct EpiUp8 {
    static constexpr bool PERM = true; static constexpr int HOOK_TILES = 0; static constexpr bool I8 = true;
    bf16* U; const float* cw; const float* cb; const float* SH; const float* SW;
    __device__ __forceinline__ void hook(f32x4 (&)[2][2][4][2], const Unit&, int, int, int, int, int) const {}
    __device__ __forceinline__ void operator()(const f32x4 (&acc)[2][2][4][2], const Unit& u, int wr, int wc, int fr, int fq) const {
        const int Rbase = 252 * u.pm - 1 + 126 * wr;
        const int ch0 = u.pn * 128 + wc * 32 + 8 * fq;
        float shr[8];
#pragma unroll
        for (int k = 0; k < 8; ++k) { const int R = Rbase + 16 * k + fr; shr[k] = SH[min(max(R, 0), T - 1)]; }
        float w0[8], w1[8], w2[8], bb[8], swg[8], swv[8];
        { const f32x4 a0 = *(const f32x4*)(cw + ch0), a1 = *(const f32x4*)(cw + ch0 + 4), b0 = *(const f32x4*)(cw + DFF + ch0), b1 = *(const f32x4*)(cw + DFF + ch0 + 4);
          const f32x4 c0 = *(const f32x4*)(cw + 2 * DFF + ch0), c1 = *(const f32x4*)(cw + 2 * DFF + ch0 + 4), d0 = *(const f32x4*)(cb + ch0), d1 = *(const f32x4*)(cb + ch0 + 4);
          const float* sp = SW + u.pn * 256 + wc * 32 + 8 * fq;
          const f32x4 e0 = *(const f32x4*)sp, e1 = *(const f32x4*)(sp + 4), f0 = *(const f32x4*)(sp + 128), f1 = *(const f32x4*)(sp + 132);
#pragma unroll
          for (int q = 0; q < 4; ++q) { w0[q] = a0[q]; w0[4 + q] = a1[q]; w1[q] = b0[q]; w1[4 + q] = b1[q]; w2[q] = c0[q]; w2[4 + q] = c1[q]; bb[q] = d0[q]; bb[4 + q] = d1[q];
              swg[q] = e0[q]; swg[4 + q] = e1[q]; swv[q] = f0[q]; swv[4 + q] = f1[q]; } }
#define U8G(k, cc) ((float)__builtin_bit_cast(i32x4, acc[(k) >> 2][0][(k) & 3][(cc) >> 2])[(cc) & 3] * shr[k])
#define U8V(k, cc) ((float)__builtin_bit_cast(i32x4, acc[(k) >> 2][1][(k) & 3][(cc) >> 2])[(cc) & 3] * shr[k] * swv[cc])
#pragma unroll
        for (int cc = 0; cc < 8; ++cc) { w0[cc] *= swg[cc]; w1[cc] *= swg[cc]; w2[cc] *= swg[cc]; }
        int lfr = fr;
        float spp[8], spc[8], snc[8], snn[8], gcur[8], gnx[8];
#pragma unroll
        for (int cc = 0; cc < 8; ++cc) { spp[cc] = 0.f; gcur[cc] = U8G(0, cc); spc[cc] = dpp_ror1(gcur[cc]); snc[cc] = dpp_ror15(gcur[cc]); }
#pragma unroll
        for (int k = 0; k < 8; ++k) {
            asm volatile("" : "+v"(lfr));
            if (k < 7) {
#pragma unroll
                for (int cc = 0; cc < 8; ++cc) { gnx[cc] = U8G(k + 1, cc); snn[cc] = dpp_ror15(gnx[cc]); }
            } else {
#pragma unroll
                for (int cc = 0; cc < 8; ++cc) { gnx[cc] = 0.f; snn[cc] = 0.f; }
            }
            const int y = 16 * k + lfr, R = Rbase + y;
            const bool fst = (R < TL) ? ((R & (SEQ - 1)) == 0) : ((R & 255) == 0), lst = (R < TL) ? ((R & (SEQ - 1)) == SEQ - 1) : ((R & 255) == 255);
            float res[8];
#pragma unroll
            for (int cc = 0; cc < 8; ++cc) {
                float P = (lfr > 0) ? spc[cc] : spp[cc], N = (lfr < 15) ? snc[cc] : snn[cc];
                P = fst ? 0.f : P; N = lst ? 0.f : N;
                const float a = w0[cc] * P + w1[cc] * gcur[cc] + w2[cc] * N + bb[cc];
                res[cc] = a * sigmoidf_(a) * U8V(k, cc);
            }
            if (y >= 1 && y <= 126 && R < T) { u32x4 w; w.x = cvt_pk_bf16(res[0], res[1]); w.y = cvt_pk_bf16(res[2], res[3]); w.z = cvt_pk_bf16(res[4], res[5]); w.w = cvt_pk_bf16(res[6], res[7]);
                *(u32x4*)(U + (size_t)R * DFF + ch0) = w; }
            if (k < 7) {
#pragma unroll
                for (int cc = 0; cc < 8; ++cc) { spp[cc] = spc[cc]; gcur[cc] = gnx[cc]; spc[cc] = dpp_ror1(gnx[cc]); snc[cc] = snn[cc]; }
            }
        }
#undef U8G
#undef U8V
    }
};
struct EpiV8 {
    static constexpr bool PERM = true; static constexpr int HOOK_TILES = 0; static constexpr bool I8 = true;
    bf16* U; const float* SH; const float* SW;
    __device__ __forceinline__ void hook(f32x4 (&)[2][2][4][2], const Unit&, int, int, int, int, int) const {}
    __device__ __forceinline__ void operator()(const f32x4 (&acc)[2][2][4][2], const Unit& u, int wr, int wc, int fr, int fq) const {
        bf16* base = U + (size_t)u.pn * 256 + wc * 32 + 8 * fq;
        float shr[8]; f32x4 swc[2][2];
#pragma unroll
        for (int k = 0; k < 8; ++k) shr[k] = SH[u.pm * BM + (k >> 2) * HALF + wr * 64 + (k & 3) * 16 + fr];
#pragma unroll
        for (int bj = 0; bj < 2; ++bj)
#pragma unroll
            for (int n = 0; n < 2; ++n) swc[bj][n] = *(const f32x4*)(SW + u.pn * BM + bj * HALF + wc * 32 + 8 * fq + 4 * n);
#pragma unroll
        for (int ai = 0; ai < 2; ++ai) {
            u32x4 gg[4][2];
#pragma unroll
            for (int m = 0; m < 4; ++m)
#pragma unroll
                for (int bj = 0; bj < 2; ++bj) gg[m][bj] = *(const u32x4*)(base + (size_t)(u.pm * BM + ai * HALF + wr * 64 + m * 16 + fr) * DFF + bj * HALF);
#pragma unroll
            for (int m = 0; m < 4; ++m)
#pragma unroll
                for (int bj = 0; bj < 2; ++bj) { const u32x4 a = gg[m][bj]; const i32x4 a0 = __builtin_bit_cast(i32x4, acc[ai][bj][m][0]), a1 = __builtin_bit_cast(i32x4, acc[ai][bj][m][1]); const float rs = shr[ai * 4 + m];
                    f32x4 v0, v1;
#pragma unroll
                    for (int j = 0; j < 4; ++j) { v0[j] = (float)a0[j] * rs * swc[bj][0][j]; v1[j] = (float)a1[j] * rs * swc[bj][1][j]; }
                    u32x4 w; w.x = cvt_pk_bf16(v0[0] * bflo(a.x), v0[1] * bfhi(a.x)); w.y = cvt_pk_bf16(v0[2] * bflo(a.y), v0[3] * bfhi(a.y));
                    w.z = cvt_pk_bf16(v1[0] * bflo(a.z), v1[1] * bfhi(a.z)); w.w = cvt_pk_bf16(v1[2] * bflo(a.w), v1[3] * bfhi(a.w));
                    *(u32x4*)(base + (size_t)(u.pm * BM + ai * HALF + wr * 64 + m * 16 + fr) * DFF + bj * HALF) = w; }
            asm volatile("" ::: "memory");
        }
    }
};
struct EpiV {
    static constexpr bool PERM = true; static constexpr int HOOK_TILES = 0; static constexpr bool I8 = false;
    bf16* U;
    __device__ __forceinline__ void hook(f32x4 (&)[2][2][4][2], const Unit&, int, int, int, int, int) const {}
    __device__ __forceinline__ void operator()(const f32x4 (&acc)[2][2][4][2], const Unit& u, int wr, int wc, int fr, int fq) const {
        bf16* base = U + (size_t)u.pn * 256 + wc * 32 + 8 * fq;
#pragma unroll
        for (int ai = 0; ai < 2; ++ai) {
            u32x4 gg[4][2];
#pragma unroll
            for (int m = 0; m < 4; ++m)
#pragma unroll
                for (int bj = 0; bj < 2; ++bj) gg[m][bj] = *(const u32x4*)(base + (size_t)(u.pm * BM + ai * HALF + wr * 64 + m * 16 + fr) * DFF + bj * HALF);
#pragma unroll
            for (int m = 0; m < 4; ++m)
#pragma unroll
                for (int bj = 0; bj < 2; ++bj) { const u32x4 a = gg[m][bj]; const f32x4 v0 = acc[ai][bj][m][0], v1 = acc[ai][bj][m][1];
                    u32x4 w; w.x = cvt_pk_bf16(v0[0] * bflo(a.x), v0[1] * bfhi(a.x)); w.y = cvt_pk_bf16(v0[2] * bflo(a.y), v0[3] * bfhi(a.y));
                    w.z = cvt_pk_bf16(v1[0] * bflo(a.z), v1[1] * bfhi(a.z)); w.w = cvt_pk_bf16(v1[2] * bflo(a.w), v1[3] * bfhi(a.w));
                    *(u32x4*)(base + (size_t)(u.pm * BM + ai * HALF + wr * 64 + m * 16 + fr) * DFF + bj * HALF) = w; }
            asm volatile("" ::: "memory");
        }
    }
};
}

namespace att {
constexpr int SHM_V = 16384, SHM_K = 16384;
constexpr int OFF_V = 0, OFF_K = 2 * SHM_V, OFF_WS = 2 * SHM_V + 2 * SHM_K, OFF_TAB = OFF_WS + NWAVES * 256;
constexpr float THR = 11.5f;
#define KSWZ(row, colB) ((row) * 256 + ((colB) ^ (((row) & 7) << 4)))
#define SBAR() __builtin_amdgcn_sched_barrier(0)
__device__ __forceinline__ int crow(int r, int hi) { return (r & 3) + 8 * (r >> 2) + 4 * hi; }
__device__ __forceinline__ int v_st(int k, int c) { const int kk = (k & ~0xC) | ((k & 4) << 1) | ((k & 8) >> 1); return ((kk >> 3) * 4 + (c >> 5)) * 512 + ((kk & 7) * 32 + (c & 31)) * 2; }
__device__ __forceinline__ int v_rd_base(int lane) { return ((lane & 3) << 3) | (((lane >> 2) & 3) << 6) | (((lane >> 4) & 1) << 5) | (((lane >> 5) & 1) << 8); }
constexpr int v_rd_off(int d0, int ks, int half) { return d0 * 512 + ks * 4096 + half * 2048; }
template <int OFF> __device__ __forceinline__ s16x4 tr_read(int vb) { s16x4 r; asm volatile("ds_read_b64_tr_b16 %0, %1 offset:%2" : "=&v"(r) : "v"(vb), "i"(OFF) : "memory"); return r; }
template <int D0> __device__ __forceinline__ void pv_one(f32x16& od, int vb, bf16x8 pa0, bf16x8 pa1, bf16x8 pa2, bf16x8 pa3) {
    const s16x4 l0 = tr_read<v_rd_off(D0, 0, 0)>(vb), h0 = tr_read<v_rd_off(D0, 0, 1)>(vb), l1 = tr_read<v_rd_off(D0, 1, 0)>(vb), h1 = tr_read<v_rd_off(D0, 1, 1)>(vb);
    const s16x4 l2 = tr_read<v_rd_off(D0, 2, 0)>(vb), h2 = tr_read<v_rd_off(D0, 2, 1)>(vb), l3 = tr_read<v_rd_off(D0, 3, 0)>(vb), h3 = tr_read<v_rd_off(D0, 3, 1)>(vb);
    asm volatile("s_waitcnt lgkmcnt(0)" ::: "memory"); SBAR();
#define PK(L, H) (bf16x8){L[0], L[1], L[2], L[3], H[0], H[1], H[2], H[3]}
    od = __builtin_amdgcn_mfma_f32_32x32x16_bf16(pa0, PK(l0, h0), od, 0, 0, 0);
    od = __builtin_amdgcn_mfma_f32_32x32x16_bf16(pa1, PK(l1, h1), od, 0, 0, 0);
    od = __builtin_amdgcn_mfma_f32_32x32x16_bf16(pa2, PK(l2, h2), od, 0, 0, 0);
    od = __builtin_amdgcn_mfma_f32_32x32x16_bf16(pa3, PK(l3, h3), od, 0, 0, 0);
#undef PK
}
__device__ __forceinline__ void qkt(f32x16& p0, f32x16& p1, const LAS char* Ks, const bf16x8 (&qr)[8], int r32, int hi) {
    p0 = f32x16{}; p1 = f32x16{};
#pragma unroll
    for (int d0 = 0; d0 < 8; ++d0) { const int cb = (d0 * 16 + hi * 8) * 2;
        const bf16x8 b0 = *(const LAS bf16x8*)(Ks + KSWZ(r32, cb));
        const bf16x8 b1 = *(const LAS bf16x8*)(Ks + KSWZ(32 + r32, cb));
        p0 = __builtin_amdgcn_mfma_f32_32x32x16_bf16(b0, qr[d0], p0, 0, 0, 0);
        p1 = __builtin_amdgcn_mfma_f32_32x32x16_bf16(b1, qr[d0], p1, 0, 0, 0); }
}

__device__ __forceinline__ void attn_unit(LAS char* lds, const bf16* __restrict__ ACT, bf16* __restrict__ YC, const float* __restrict__ sink, const float* __restrict__ rpb,
                                          int kind, int b, int hh, int blk) {
    int tid_ = threadIdx.x; asm volatile("" : "+v"(tid_));
    const int tid = tid_, wid = __builtin_amdgcn_readfirstlane(tid >> 6), lane = tid & 63, r32 = lane & 31, hi = lane >> 5;
    LAS char* V_lds = lds + OFF_V; LAS char* K_lds = lds + OFF_K;
    LAS float* wsf = (LAS float*)(lds + OFF_WS) + wid * 64; LAS float* li_l = wsf; LAS float* al_l = wsf + 32;
    LAS float* tab = (LAS float*)(lds + OFF_TAB);
    const bool isA = (kind == 0 || kind == 2);
    int head, qrow0;
    if (kind == 0)      { head = hh * 4 + (wid >> 1); qrow0 = b * SEQ + blk * 64 + (wid & 1) * 32; }
    else if (kind == 1) { head = hh;                  qrow0 = b * SEQ + blk * 256 + wid * 32; }
    else if (kind == 2) { head = hh * 4 + (wid >> 1); qrow0 = TL + b * CTXL + blk * 64 + (wid & 1) * 32; }
    else                { head = hh;                  qrow0 = TL + b * CTXL + wid * 32; }
    const int qcolofs = isA ? OFF_AQ + head * 128 : OFF_NQ + head * 128;
    const int ocol = isA ? head * 128 : 1024 + head * 128;
    const int kcol = isA ? OFF_AK + hh * 128 : OFF_NK + hh * 128, vcol = isA ? OFF_AV + hh * 128 : OFF_NV + hh * 128;
    const int NT = kind == 0 ? 9 : (kind == 1 ? 15 : 4);
    const int krow0 = kind == 1 ? min(max(blk * 4 - 4, 0), 117) : 0;
    const int kp00 = blk * 64 - 128;
    if (kind == 1) { if (tid < 465) tab[tid] = rpb[head * 465 + tid] * LOG2E; }
    bf16x8 qr[8];
    { const bf16* Qw = ACT + (size_t)(qrow0 + r32) * ACTW + qcolofs + hi * 8;
#pragma unroll
      for (int d0 = 0; d0 < 8; ++d0) qr[d0] = *(const bf16x8*)(Qw + d0 * 16); }
    float m_reg, l_reg;
    if (isA) { m_reg = sink[head] * LOG2E; l_reg = 1.f; } else { m_reg = -1e30f; l_reg = 0.f; }
    f32x16 o[4] = {};
    const int sr = tid >> 4, sc = (tid & 15) * 8, vst0 = v_st(sr, sc), vst1 = v_st(32 + sr, sc);
    const int vb0 = (int)(unsigned)(uintptr_t)V_lds + v_rd_base(lane);
    bf16x8 vs0, vs1, ks0, ks1;
#define GROW(j, r) ((j) < 4 ? (size_t)(TL + b * CTXL + (j) * 64 + (r)) : (kind == 0 ? (size_t)(b * SEQ + min(max(kp00 + ((j) - 4) * 64 + (r), 0), SEQ - 1)) : (size_t)(b * SEQ + (krow0 + (j) - 4) * 64 + (r))))
#define SLOAD(j) do { const bf16* r0p = ACT + GROW((j), sr) * ACTW + sc; const bf16* r1p = ACT + GROW((j), 32 + sr) * ACTW + sc; \
        vs0 = *(const bf16x8*)(r0p + vcol); vs1 = *(const bf16x8*)(r1p + vcol); ks0 = *(const bf16x8*)(r0p + kcol); ks1 = *(const bf16x8*)(r1p + kcol); } while (0)
#define SWRITE(bb) do { *(LAS bf16x8*)(V_lds + (bb) * SHM_V + vst0) = vs0; *(LAS bf16x8*)(V_lds + (bb) * SHM_V + vst1) = vs1; const int kc = sc * 2; \
        *(LAS bf16x8*)(K_lds + (bb) * SHM_K + KSWZ(sr, kc)) = ks0; *(LAS bf16x8*)(K_lds + (bb) * SHM_K + KSWZ(32 + sr, kc)) = ks1; } while (0)
    SLOAD(0); SWRITE(0); __syncthreads();
    const int qpos = blk * 64 + (wid & 1) * 32 + r32;
    const int qgr = blk * 4 + (wid >> 1), qgc = (wid & 1) * 32 + r32;
    const int rs = min(max(qgr - 4, 0), 120), cs = min(max(qgc - 8, 0), 48);
    const int rsw = __builtin_amdgcn_readfirstlane(rs);
    for (int j = 0; j < NT; ++j) {
        const int cur = j & 1;
        if (j + 1 < NT) SLOAD(j + 1);
        const bool active = !(kind == 1 && j >= 4 && ((krow0 + j - 4 < rsw) || (krow0 + j - 4 >= rsw + 8)));
        if (active) {
        f32x16 p0, p1;
        SBAR(); qkt(p0, p1, K_lds + cur * SHM_K, qr, r32, hi);
        if (j >= 4) {
            int hiv = hi; asm volatile("" : "+v"(hiv));
            if (kind == 0) { const int kp0 = kp00 + (j - 4) * 64;
#pragma unroll
                for (int r = 0; r < 16; ++r) { const int kpa = kp0 + crow(r, hiv), kpb = kpa + 32;
                    const bool oka = ((unsigned)kpa < (unsigned)SEQ) && (kpa - qpos <= 128) && (qpos - kpa <= 128);
                    const bool okb = ((unsigned)kpb < (unsigned)SEQ) && (kpb - qpos <= 128) && (qpos - kpb <= 128);
                    p0[r] = oka ? p0[r] : -1e30f; p1[r] = okb ? p1[r] : -1e30f; }
            } else { const int keyrow = krow0 + j - 4; const bool rowok = (keyrow >= rs) && (keyrow < rs + 8);
                const int dr = min(max(keyrow - qgr + 7, 0), 14); const LAS float* trow = tab + dr * 31;
#pragma unroll
                for (int r = 0; r < 16; ++r) { const int ka = crow(r, hiv);
                    const bool oka = rowok && ((unsigned)(ka - cs) < 16u);
                    const float ba = trow[min(max(ka - qgc + 15, 0), 30)];
                    p0[r] = oka ? p0[r] + ba : -1e30f; }
                asm volatile("" ::: "memory");
#pragma unroll
                for (int r = 0; r < 16; ++r) { const int kb2 = crow(r, hiv) + 32;
                    const bool okb = rowok && ((unsigned)(kb2 - cs) < 16u);
                    const float bb = trow[min(max(kb2 - qgc + 15, 0), 30)];
                    p1[r] = okb ? p1[r] + bb : -1e30f; }
            }
        }
        float pmax = p0[0];
#pragma unroll
        for (int r = 1; r < 16; ++r) pmax = fmaxf(pmax, p0[r]);
#pragma unroll
        for (int r = 0; r < 16; ++r) pmax = fmaxf(pmax, p1[r]);
        { auto rr = __builtin_amdgcn_permlane32_swap(__float_as_uint(pmax), __float_as_uint(pmax), false, false); pmax = fmaxf(__uint_as_float(rr[0]), __uint_as_float(rr[1])); }
        float mn, alpha;
        if (__all(pmax - m_reg <= THR)) { mn = m_reg; alpha = 1.f; }
        else { mn = fmaxf(m_reg, pmax); alpha = fast_exp2(m_reg - mn); m_reg = mn; }
#pragma unroll
        for (int r = 0; r < 16; ++r) { p0[r] = fast_exp2(p0[r] - mn); p1[r] = fast_exp2(p1[r] - mn); }
        float ps = 0.f;
#pragma unroll
        for (int r = 0; r < 16; ++r) ps += p0[r];
#pragma unroll
        for (int r = 0; r < 16; ++r) ps += p1[r];
        { auto rr = __builtin_amdgcn_permlane32_swap(__float_as_uint(ps), __float_as_uint(ps), false, false); ps = __uint_as_float(rr[0]) + __uint_as_float(rr[1]); }
        l_reg = l_reg * alpha + ps;
        bf16x8 pa0, pa1, pa2, pa3;
#define PK4(P, BASE, OUT) do { unsigned a0 = cvt_pk_bf16(P[BASE + 0], P[BASE + 1]), a1 = cvt_pk_bf16(P[BASE + 2], P[BASE + 3]); \
        unsigned b0 = cvt_pk_bf16(P[BASE + 4], P[BASE + 5]), b1 = cvt_pk_bf16(P[BASE + 6], P[BASE + 7]); \
        auto r0 = __builtin_amdgcn_permlane32_swap(a0, b0, false, false); auto r1 = __builtin_amdgcn_permlane32_swap(a1, b1, false, false); \
        u32x4 w = {r0[0], r1[0], r0[1], r1[1]}; OUT = __builtin_bit_cast(bf16x8, w); } while (0)
        PK4(p0, 0, pa0); PK4(p0, 8, pa1); PK4(p1, 0, pa2); PK4(p1, 8, pa3);
#undef PK4
        if (__any(alpha < 1.f)) { if (hi == 0) al_l[r32] = alpha; asm volatile("s_waitcnt lgkmcnt(0)" ::: "memory");
#pragma unroll
            for (int d = 0; d < 4; ++d)
#pragma unroll
                for (int r = 0; r < 16; ++r) o[d][r] *= al_l[crow(r, hi)]; }
        SBAR();
        { const int vb = vb0 + cur * SHM_V; pv_one<0>(o[0], vb, pa0, pa1, pa2, pa3); pv_one<1>(o[1], vb, pa0, pa1, pa2, pa3); pv_one<2>(o[2], vb, pa0, pa1, pa2, pa3); pv_one<3>(o[3], vb, pa0, pa1, pa2, pa3); }
        }
        if (j + 1 < NT) SWRITE((j + 1) & 1);
        __syncthreads();
    }
    if (hi == 0) li_l[r32] = l_reg;
    asm volatile("s_waitcnt lgkmcnt(0)" ::: "memory");
    bf16* Ow = YC + (size_t)qrow0 * DM + ocol + r32;
    int hie = hi; asm volatile("" : "+v"(hie));
#pragma unroll
    for (int r = 0; r < 16; ++r) { const int orow = crow(r, hie); const float rl = fast_rcp(li_l[orow]);
#pragma unroll
        for (int d0 = 0; d0 < 4; ++d0) { const float v = o[d0][r] * rl; Ow[(size_t)orow * DM + d0 * 32] = (bf16)(cvt_pk_bf16(v, v) & 0xffffu); } }
#undef SLOAD
#undef SWRITE
#undef GROW
}
}

struct Args { const float* in[22]; float* out; unsigned char* ws; int ph_lo, ph_hi; };

struct Frame {
    LAS unsigned char* lds; int tid, lane, wave, G, c;
    unsigned char* ws;
    const float *x, *cvec, *ctx, *c_ctx, *w_mod, *b_mod, *g_mix, *w_in, *a_sink, *na_rpb, *w_pool, *pool_scale, *w_fnet, *w_branch, *w_out, *g_ffn, *w_ff_gate, *w_ff_val, *ff_conv_w, *ff_conv_b, *w_ff_down, *g_final;
    float* out;
};

__device__ __forceinline__ int map_row(int kind, int n) {
    if (kind == 1) { if (n < 1280) { const int head = n >> 7, d = n & 127, hf = d >> 6, i = d & 63; const int p = (i < 32) ? 2 * i : 2 * (i - 32) + 1; return head * 128 + hf * 64 + p; } return n; }
    if (kind == 2) return (n >> 7) * 256 + (n & 127);
    if (kind == 3) return (n >> 7) * 256 + 128 + (n & 127);
    return n;
}
__device__ __forceinline__ void tr_item(const float* __restrict__ W, int ldw, int nblk, int item, bf16* __restrict__ WT, int ldt, int kofs, int mapkind, const float* __restrict__ kscale, LAS float* scr, int lane, unsigned* cmax = nullptr, int cbase = 0) {
    const int kb = item / nblk, nb = item - kb * nblk, k0 = 64 * kb, n0 = 32 * nb;
    float wv[32];
#pragma unroll
    for (int i = 0; i < 32; ++i) { const int kk = 2 * i + (lane >> 5); wv[i] = W[(size_t)(k0 + kk) * ldw + n0 + (lane & 31)]; }
    if (kscale) {
#pragma unroll
        for (int i = 0; i < 32; ++i) wv[i] *= kscale[k0 + 2 * i + (lane >> 5)]; }
    if (cmax != nullptr && n0 >= cbase) {
        float mx = 0.f;
#pragma unroll
        for (int i = 0; i < 32; ++i) mx = fmaxf(mx, fabsf(wv[i]));
        mx = fmaxf(mx, __shfl_xor(mx, 32));
        if (lane < 32) atomicMax(cmax + (n0 - cbase) + lane, __float_as_uint(mx));
    }
#pragma unroll
    for (int i = 0; i < 32; ++i) { const int kk = 2 * i + (lane >> 5); scr[kk * 33 + (lane & 31)] = wv[i]; }
    LDS_WAIT(); asm volatile("" ::: "memory");
    const int cch = lane & 7;
#pragma unroll
    for (int j = 0; j < 4; ++j) { const int n = (lane >> 3) + 8 * j; const LAS float* s = scr + (8 * cch) * 33 + n;
        u32x4 o; o.x = cvt_pk_bf16(s[0 * 33], s[1 * 33]); o.y = cvt_pk_bf16(s[2 * 33], s[3 * 33]); o.z = cvt_pk_bf16(s[4 * 33], s[5 * 33]); o.w = cvt_pk_bf16(s[6 * 33], s[7 * 33]);
        *(u32x4*)(WT + (size_t)map_row(mapkind, n0 + n) * ldt + kofs + k0 + 8 * cch) = o; }
    LDS_WAIT(); asm volatile("" ::: "memory");
}

__device__ __forceinline__ void phase_prologue(Frame& F, bool do_mod) {
    const int gw = F.c * NWAVES + F.wave, NGW = F.G * NWAVES, lane = F.lane;
    unsigned char* ws = F.ws;
    LAS float* sv = (LAS float*)(F.lds + 73728);
    for (int i = F.tid; i < 3 * DM; i += NWAVES * 64) { const int v = i / DM, k = i - v * DM; const float cc = v < 2 ? F.cvec[v * DM + k] : F.c_ctx[k]; sv[i] = cc * sigmoidf_(cc); }
    __syncthreads();
    float* MOD = (float*)(ws + WS_MOD);
    if (do_mod) for (int it = gw; it < 2 * 96 * 16; it += NGW) {
        const int l = it / (96 * 16), r = it - l * 96 * 16, cbk = r >> 4, kc = r & 15;
        const int col = cbk * 256 + lane * 4, k0 = kc * 256;
        const float* Wp = F.w_mod + (size_t)l * DM * MODW + (size_t)k0 * MODW + col;
        f32x4 a0 = {0.f, 0.f, 0.f, 0.f}, a1 = a0, a2 = a0;
#pragma unroll 8
        for (int k = 0; k < 256; ++k) { const f32x4 w = *(const f32x4*)(Wp + (size_t)k * MODW); const float s0 = sv[k0 + k], s1 = sv[DM + k0 + k], s2 = sv[2 * DM + k0 + k]; a0 += w * s0; a1 += w * s1; a2 += w * s2; }
        if (kc == 0) { const f32x4 bb = *(const f32x4*)(F.b_mod + (size_t)l * MODW + col); a0 += bb; a1 += bb; a2 += bb; }
        float* pp = (float*)(ws + WS_PART) + ((size_t)(l * 16 + kc) * 3) * MODW + col;
        *(f32x4*)pp = a0; *(f32x4*)(pp + MODW) = a1; *(f32x4*)(pp + 2 * MODW) = a2;
    }
    { float* rope = (float*)(ws + WS_ROPE);
      for (int i = gw * 64 + lane; i < 128 * 32; i += NGW * 64) { const int pos = i >> 5, fi = i & 31; const float inv = exp2f(-(float)fi * (13.287712379549449f / 32.0f)); float sn, cs; sincosf((float)pos * inv, &sn, &cs); rope[2 * i] = cs; rope[2 * i + 1] = sn; }
      bf16* tab1 = (bf16*)(ws + WS_TAB1);
      for (int i = gw * 64 + lane; i < 512 * 256; i += NGW * 64) { const int mp = i >> 8, cc = i & 255, part = mp >> 8, m = mp & 255; const float xr = (float)((m * cc) & 255) * (1.0f / 256.0f);
          const float v = part ? -__builtin_amdgcn_sinf(xr) : __builtin_amdgcn_cosf(xr); tab1[i] = (bf16)(cvt_pk_bf16(v * 0.0625f, 0.f) & 0xffffu); }
      bf16* dftc = (bf16*)(ws + WS_DFTC);
      for (int i = gw * 64 + lane; i < 256 * 512; i += NGW * 64) { const int k = i >> 9, cc = i & 511, part = cc >> 8, n = cc & 255; const float xr = (float)((k * n) & 255) * (1.0f / 256.0f);
          const float v = part ? __builtin_amdgcn_sinf(xr) : __builtin_amdgcn_cosf(xr); dftc[i] = (bf16)(cvt_pk_bf16(v * 0.0625f, 0.f) & 0xffffu); }
      bf16* dfta = (bf16*)(ws + WS_DFTA);
      const float sc = 0.011048543456039806f;
      for (int k = 1 + gw; k <= SEQ / 4; k += NGW) { bf16* rowp = dfta + (size_t)k * pg8::ZK;
          for (int s = 0; s < 16; ++s) { const int c0 = s * 512 + lane * 8; float v[8];
#pragma unroll
              for (int e = 0; e < 8; ++e) { const int cc = c0 + e, blk = cc >> 11, n = 2 * (cc & 2047) + (blk & 1); const float xr = (float)((k * n) & 8191) * (1.0f / 8192.0f);
                  v[e] = ((blk < 2) ? __builtin_amdgcn_cosf(xr) : __builtin_amdgcn_sinf(xr)) * sc; }
              u32x4 w; w.x = cvt_pk_bf16(v[0], v[1]); w.y = cvt_pk_bf16(v[2], v[3]); w.z = cvt_pk_bf16(v[4], v[5]); w.w = cvt_pk_bf16(v[6], v[7]); *(u32x4*)(rowp + c0) = w; } }
    }
    { f32x4* xd = (f32x4*)(ws + WS_X + (size_t)TL * DM * 4); const f32x4* xs = (const f32x4*)F.ctx; _Pragma("unroll 4") for (size_t i = (size_t)gw * 64 + lane; i < (size_t)TC * DM / 4; i += (size_t)NGW * 64) xd[i] = xs[i]; }
    { bf16* wp = (bf16*)(ws + WS_WPOOLB); for (size_t i = (size_t)gw * 64 + lane; i < (size_t)2 * 4 * 256 * 256; i += (size_t)NGW * 64) wp[i] = (bf16)(cvt_pk_bf16(F.w_pool[i], 0.f) & 0xffffu);
      bf16* wf = (bf16*)(ws + WS_WFNETB); for (size_t i = (size_t)gw * 64 + lane; i < (size_t)2 * 1024 * 1024; i += (size_t)NGW * 64) wf[i] = (bf16)(cvt_pk_bf16(F.w_fnet[i], 0.f) & 0xffffu); }
    LAS float* scr = (LAS float*)(F.lds + F.wave * 8704);
    constexpr int I_IN = 64 * 720, I_BR = 16 * 128, I_OUT = 64 * 128, I_UP = 64 * 344, I_DN = 172 * 128;
    constexpr int I_LAYER = I_IN + 4 * I_BR + I_OUT + 2 * I_UP + I_DN;
    for (int it = gw; it < 2 * I_LAYER; it += NGW) {
        const int l = it / I_LAYER; int r = it - l * I_LAYER;
        unsigned char* wl = ws + WS_WL + (size_t)l * WL_STRIDE;
        if (r < I_IN) { tr_item(F.w_in + (size_t)l * DM * NIN, NIN, 720, r, (bf16*)(wl + WL_IN), DM, 0, 1, nullptr, scr, lane, (unsigned*)(ws + WS_CM) + l * 16384, 6656); continue; } r -= I_IN;
        if (r < I_BR) { tr_item(F.w_branch + ((size_t)l * 4 + 0) * 1024 * DM, DM, 128, r, (bf16*)(wl + WL_M), DM, 0, 0, nullptr, scr, lane); continue; } r -= I_BR;
        if (r < I_BR) { tr_item(F.w_branch + ((size_t)l * 4 + 1) * 1024 * DM, DM, 128, r, (bf16*)(wl + WL_M), DM, 1024, 0, nullptr, scr, lane); continue; } r -= I_BR;
        if (r < I_BR) { tr_item(F.w_branch + ((size_t)l * 4 + 2) * 1024 * DM, DM, 128, r, (bf16*)(ws + WS_WB2ST) + (size_t)l * DM * 1024, 1024, 0, 0, F.pool_scale + l * 1024, scr, lane); continue; } r -= I_BR;
        if (r < I_BR) { tr_item(F.w_branch + ((size_t)l * 4 + 3) * 1024 * DM, DM, 128, r, (bf16*)(ws + WS_WB3T) + (size_t)l * DM * 1024, 1024, 0, 0, nullptr, scr, lane); continue; } r -= I_BR;
        if (r < I_OUT) { tr_item(F.w_out + (size_t)l * DM * DM, DM, 128, r, (bf16*)(wl + WL_OUT), DM, 0, 0, nullptr, scr, lane); continue; } r -= I_OUT;
        if (r < I_UP) { tr_item(F.w_ff_gate + (size_t)l * DM * DFF, DFF, 344, r, (bf16*)(wl + WL_UP), DM, 0, 2, nullptr, scr, lane, (unsigned*)(ws + WS_CM2) + l * DFF, 0); continue; } r -= I_UP;
        if (r < I_UP) { tr_item(F.w_ff_val + (size_t)l * DM * DFF, DFF, 344, r, (bf16*)(wl + WL_UP), DM, 0, 3, nullptr, scr, lane, (unsigned*)(ws + WS_CM3) + l * DFF, 0); continue; } r -= I_UP;
        tr_item(F.w_ff_down + (size_t)l * DFF * DM, DM, 128, r, (bf16*)(wl + WL_DN), DFF, 0, 0, nullptr, scr, lane);
    }
}

__device__ __forceinline__ float mod_from_parts(const float* __restrict__ part, int l, int v, int idx) {
    float s = 0.f;
#pragma unroll
    for (int kc = 0; kc < 16; ++kc) s += part[((size_t)(l * 16 + kc) * 3 + v) * MODW + idx];
    return s;
}
__device__ __forceinline__ void norm_rows(Frame& F, const float* __restrict__ src_lat, const float* src_ctx, const float* __restrict__ gvec, const float* __restrict__ modl, int sh_off, int sc_off, bf16* __restrict__ H, int nrows, const float* __restrict__ slab, float* xctx_out, unsigned* __restrict__ H8, float* __restrict__ SHs, const float* __restrict__ part = nullptr, int part_l = 0) {
    const int gw = F.wave * F.G + F.c, NGW = F.G * NWAVES, lane = F.lane;
    LAS float* LA = (LAS float*)F.lds;
    for (int i = F.tid; i < 3 * DM; i += NWAVES * 64) { const int v = i / DM, k = i - v * DM;
        const float sc = part ? mod_from_parts(part, part_l, v, sc_off + k) : modl[(size_t)v * MODW + sc_off + k], sh = part ? mod_from_parts(part, part_l, v, sh_off + k) : modl[(size_t)v * MODW + sh_off + k];
        LA[i] = gvec[k] * (sc + 1.0f); LA[3 * DM + i] = sh; }
    __syncthreads();
    if (gw < nrows) {
        f32x4 v[16];
        { const float* xr = (gw < TL ? src_lat + (size_t)gw * DM : src_ctx + (size_t)(gw - TL) * DM) + lane * 4;
#pragma unroll
          for (int j = 0; j < 16; ++j) v[j] = *(const f32x4*)(xr + 256 * j); }
        for (int row = gw; row < nrows; row += NGW) {
            const int nrow = row + NGW; f32x4 vn[16];
            if (nrow < nrows) { const float* xr = (nrow < TL ? src_lat + (size_t)nrow * DM : src_ctx + (size_t)(nrow - TL) * DM) + lane * 4;
#pragma unroll
                for (int j = 0; j < 16; ++j) vn[j] = *(const f32x4*)(xr + 256 * j); }
            if (slab != nullptr && row >= TL) {
                const float* sp = slab + (size_t)(row - TL) * DM + lane * 4;
#pragma unroll
                for (int p = 0; p < 8; ++p)
#pragma unroll
                    for (int j = 0; j < 16; ++j) v[j] += *(const f32x4*)(sp + (size_t)p * TC * DM + 256 * j);
                float* xo = xctx_out + (size_t)(row - TL) * DM + lane * 4;
#pragma unroll
                for (int j = 0; j < 16; ++j) *(f32x4*)(xo + 256 * j) = v[j];
            }
            float ss = 0.f;
#pragma unroll
            for (int j = 0; j < 16; ++j) ss += (v[j][0] * v[j][0] + v[j][1] * v[j][1]) + (v[j][2] * v[j][2] + v[j][3] * v[j][3]);
            const float rstd = rsqrtf(wave_sum(ss) * (1.0f / DM) + EPS);
            const int var = row < SEQ ? 0 : (row < TL ? 1 : 2);
            const LAS float* pa = LA + var * DM + lane * 4; const LAS float* pb = pa + 3 * DM;
            bf16* hp = H + (size_t)row * DM + lane * 4;
            float amax = 0.f;
#pragma unroll
            for (int j = 0; j < 16; ++j) { const f32x4 a = *(const LAS f32x4*)(pa + 256 * j), b = *(const LAS f32x4*)(pb + 256 * j);
                const f32x4 y = v[j] * rstd * a + b; if (H != nullptr) { u32x2 w; w.x = cvt_pk_bf16(y[0], y[1]); w.y = cvt_pk_bf16(y[2], y[3]); *(u32x2*)(hp + 256 * j) = w; }
                v[j] = y; amax = fmaxf(fmaxf(amax, fmaxf(fabsf(y[0]), fabsf(y[1]))), fmaxf(fabsf(y[2]), fabsf(y[3]))); }
            if (H8 != nullptr) {
#pragma unroll
                for (int o = 1; o < 64; o <<= 1) amax = fmaxf(amax, __shfl_xor(amax, o));
                amax = fmaxf(amax, 1e-20f); const float qs = 127.0f / amax;
                if (lane == 0) SHs[row] = amax * (1.0f / 127.0f);
                unsigned* qp = H8 + (size_t)row * (DM / 4) + lane;
#pragma unroll
                for (int j = 0; j < 16; ++j) { const int q0 = (int)__builtin_rintf(v[j][0] * qs), q1 = (int)__builtin_rintf(v[j][1] * qs), q2 = (int)__builtin_rintf(v[j][2] * qs), q3 = (int)__builtin_rintf(v[j][3] * qs);
                    qp[64 * j] = (unsigned)(q0 & 0xff) | ((unsigned)(q1 & 0xff) << 8) | ((unsigned)(q2 & 0xff) << 16) | ((unsigned)(q3 & 0xff) << 24); }
            }
            if (nrow < nrows) {
#pragma unroll
                for (int j = 0; j < 16; ++j) v[j] = vn[j]; }
        }
    }
    __syncthreads();
}
__device__ __forceinline__ void final_norm(Frame& F, const float* __restrict__ X) {
    const int gw = F.c * NWAVES + F.wave, NGW = F.G * NWAVES, lane = F.lane;
    f32x4 g[16];
#pragma unroll
    for (int j = 0; j < 16; ++j) g[j] = *(const f32x4*)(F.g_final + lane * 4 + 256 * j);
    if (gw < TL) {
        f32x4 v[16];
        { const float* xr = X + (size_t)gw * DM + lane * 4;
#pragma unroll
          for (int j = 0; j < 16; ++j) v[j] = *(const f32x4*)(xr + 256 * j); }
        for (int row = gw; row < TL; row += NGW) {
            const int nrow = row + NGW; f32x4 vn[16];
            if (nrow < TL) { const float* xr = X + (size_t)nrow * DM + lane * 4;
#pragma unroll
                for (int j = 0; j < 16; ++j) vn[j] = *(const f32x4*)(xr + 256 * j); }
            float ss = 0.f;
#pragma unroll
            for (int j = 0; j < 16; ++j) ss += (v[j][0] * v[j][0] + v[j][1] * v[j][1]) + (v[j][2] * v[j][2] + v[j][3] * v[j][3]);
            const float rstd = rsqrtf(wave_sum(ss) * (1.0f / DM) + EPS);
            float* __restrict__ op = F.out + (size_t)row * DM + lane * 4;
#pragma unroll
            for (int j = 0; j < 16; ++j) *(f32x4*)(op + 256 * j) = v[j] * rstd * g[j];
            if (nrow < TL) {
#pragma unroll
                for (int j = 0; j < 16; ++j) v[j] = vn[j]; }
        }
    }
}
__device__ __forceinline__ void pool_diff(Frame& F, const bf16* __restrict__ ACT, bf16* __restrict__ YC, int nrows) {
    const size_t nth = (size_t)F.G * NWAVES * 64, t0 = (size_t)(F.c * NWAVES + F.wave) * 64 + F.lane;
    for (size_t i = t0; i < (size_t)nrows * 128; i += nth) {
        const int row = (int)(i >> 7), ch = (int)(i & 127) * 8, g = ch >> 8, w = 2 << g;
        int t, n; if (row < TL) { t = row & (SEQ - 1); n = SEQ; } else { t = (row - TL) & 255; n = CTXL; }
        const int base = row - t;
        const int lo = max(t - w / 2, 0), hi = min(t + w / 2, n);
        u32x4 a[16];
#pragma unroll
        for (int q = 0; q < 16; ++q) { const int tq = min(lo + q, n - 1); a[q] = *(const u32x4*)(ACT + (size_t)(base + tq) * ACTW + OFF_PU + ch); }
        const u32x4 c = *(const u32x4*)(ACT + (size_t)row * ACTW + OFF_PU + ch);
        float s[8] = {0.f, 0.f, 0.f, 0.f, 0.f, 0.f, 0.f, 0.f};
#pragma unroll
        for (int q = 0; q < 16; ++q) { const float wq = (lo + q < hi) ? 1.0f : 0.0f;
            s[0] += wq * bflo(a[q].x); s[1] += wq * bfhi(a[q].x); s[2] += wq * bflo(a[q].y); s[3] += wq * bfhi(a[q].y); s[4] += wq * bflo(a[q].z); s[5] += wq * bfhi(a[q].z); s[6] += wq * bflo(a[q].w); s[7] += wq * bfhi(a[q].w); }
        const float inv = 1.0f / (float)(hi - lo);
        u32x4 o; o.x = cvt_pk_bf16(s[0] * inv - bflo(c.x), s[1] * inv - bfhi(c.x)); o.y = cvt_pk_bf16(s[2] * inv - bflo(c.y), s[3] * inv - bfhi(c.y));
        o.z = cvt_pk_bf16(s[4] * inv - bflo(c.z), s[5] * inv - bfhi(c.z)); o.w = cvt_pk_bf16(s[6] * inv - bflo(c.w), s[7] * inv - bfhi(c.w));
        *(u32x4*)(YC + (size_t)row * DM + 2048 + ch) = o;
    }
}

__device__ __forceinline__ void quant_gate_weights(Frame& F) {
    const int gw = F.c * NWAVES + F.wave, NGW = F.G * NWAVES, lane = F.lane;
    unsigned char* ws = F.ws;
    for (int it = gw; it < 2 * NUP; it += NGW) {
        const int l = it / NUP, ri = it - l * NUP, j = (ri >> 8) * 128 + (ri & 127); const bool isval = (ri & 255) >= 128;
        const float cm = fmaxf(__uint_as_float(((const unsigned*)(ws + (isval ? WS_CM3 : WS_CM2)))[l * DFF + j]), 1e-30f), qs = 127.0f / cm;
        if (lane == 0) ((float*)(ws + WS_SWUP))[it] = cm * (1.0f / 127.0f);
        const bf16* src = (const bf16*)(ws + WS_WL + (size_t)l * WL_STRIDE + WL_UP) + (size_t)ri * DM + lane * 8;
        u32x2* dst = (u32x2*)(ws + (l == 0 ? WS_WV8 : WS_WGA8) + (size_t)ri * DM) + lane;
        u32x4 a[8];
#pragma unroll
        for (int jj = 0; jj < 8; ++jj) a[jj] = *(const u32x4*)(src + 512 * jj);
#pragma unroll
        for (int jj = 0; jj < 8; ++jj) { const float f[8] = {bflo(a[jj].x), bfhi(a[jj].x), bflo(a[jj].y), bfhi(a[jj].y), bflo(a[jj].z), bfhi(a[jj].z), bflo(a[jj].w), bfhi(a[jj].w)}; unsigned q[8];
#pragma unroll
            for (int e = 0; e < 8; ++e) q[e] = (unsigned)((int)__builtin_rintf(fminf(fmaxf(f[e] * qs, -127.f), 127.f)) & 0xff);
            u32x2 w; w.x = q[0] | (q[1] << 8) | (q[2] << 16) | (q[3] << 24); w.y = q[4] | (q[5] << 8) | (q[6] << 16) | (q[7] << 24); dst[64 * jj] = w; }
    }
    for (int it = gw; it < 2 * 16384; it += NGW) {
        const int l = it >> 14, n = it & 16383;
        const float cm = fmaxf(__uint_as_float(((const unsigned*)(ws + WS_CM))[it]), 1e-30f), qs = 127.0f / cm;
        if (lane == 0) ((float*)(ws + WS_SW))[it] = cm * (1.0f / 127.0f);
        const bf16* src = (const bf16*)(ws + WS_WL + (size_t)l * WL_STRIDE + WL_IN) + (size_t)(6656 + n) * DM + lane * 8;
        u32x2* dst = (u32x2*)(ws + WS_WG8 + ((size_t)l * 16384 + n) * DM) + lane;
        u32x4 a[8];
#pragma unroll
        for (int j = 0; j < 8; ++j) a[j] = *(const u32x4*)(src + 512 * j);
#pragma unroll
        for (int j = 0; j < 8; ++j) { const float f[8] = {bflo(a[j].x), bfhi(a[j].x), bflo(a[j].y), bfhi(a[j].y), bflo(a[j].z), bfhi(a[j].z), bflo(a[j].w), bfhi(a[j].w)}; unsigned q[8];
#pragma unroll
            for (int e = 0; e < 8; ++e) q[e] = (unsigned)((int)__builtin_rintf(fminf(fmaxf(f[e] * qs, -127.f), 127.f)) & 0xff);
            u32x2 w; w.x = q[0] | (q[1] << 8) | (q[2] << 16) | (q[3] << 24); w.y = q[4] | (q[5] << 8) | (q[6] << 16) | (q[7] << 24); dst[64 * j] = w; }
    }
}

__device__ __forceinline__ void dft_specials(Frame& F, const bf16* __restrict__ ZT, bf16* __restrict__ YC, float* __restrict__ E4, const bf16* __restrict__ ACT, const bf16* __restrict__ TAB1) {
    const int gw = F.c * NWAVES + F.wave, NGW = F.G * NWAVES, lane = F.lane;
    for (int it = gw; it < 8 * 256; it += NGW) {
        const int z = it >> 8, ch = it & 255, b = z >> 2, g = z & 3;
        const bf16* zr = ZT + ((size_t)z * 256 + ch) * pg8::ZK;
        u32x4 ve[4], vo[4];
#pragma unroll
        for (int j = 0; j < 4; ++j) { ve[j] = *(const u32x4*)(zr + (size_t)(j * 64 + lane) * 8); vo[j] = *(const u32x4*)(zr + 2048 + (size_t)(j * 64 + lane) * 8); }
        float e4;
        { const unsigned* up = (const unsigned*)(ACT + (size_t)(b * SEQ + SEQ / 2) * ACTW + OFF_FU + g * 256) + lane * 2; const unsigned* tp = (const unsigned*)(TAB1 + (size_t)ch * 256) + lane * 2;
          const unsigned u0 = up[0], u1 = up[1], t0 = tp[0], t1 = tp[1];
          e4 = wave_sum((bflo(u0) * bflo(t0) + bfhi(u0) * bfhi(t0)) + (bflo(u1) * bflo(t1) + bfhi(u1) * bfhi(t1))); }
        float se = 0.f, so = 0.f;
#pragma unroll
        for (int j = 0; j < 4; ++j) { se += (bflo(ve[j].x) + bfhi(ve[j].x)) + (bflo(ve[j].y) + bfhi(ve[j].y)) + (bflo(ve[j].z) + bfhi(ve[j].z)) + (bflo(ve[j].w) + bfhi(ve[j].w));
            so += (bflo(vo[j].x) + bfhi(vo[j].x)) + (bflo(vo[j].y) + bfhi(vo[j].y)) + (bflo(vo[j].z) + bfhi(vo[j].z)) + (bflo(vo[j].w) + bfhi(vo[j].w)); }
        se = wave_sum(se) + e4; so = wave_sum(so);
        if (lane == 0) { const float sc = 0.011048543456039806f; bf16* yb = YC + (size_t)b * SEQ * DM + 3072 + g * 256 + ch;
            yb[0] = (bf16)(cvt_pk_bf16((se + so) * sc, 0.f) & 0xffffu); yb[(size_t)(SEQ / 2) * DM] = (bf16)(cvt_pk_bf16((se - so) * sc, 0.f) & 0xffffu); E4[it] = e4 * sc; }
    }
}
__device__ __forceinline__ void dft_combine(Frame& F, const float* __restrict__ CS, const float* __restrict__ E4, bf16* __restrict__ YC) {
    const int gw = F.c * NWAVES + F.wave, NGW = F.G * NWAVES, lane = F.lane;
    const size_t PS = (size_t)8 * 2048 * 256;
    const size_t nth = (size_t)NGW * 64, t0 = (size_t)gw * 64 + lane, NI = (size_t)8 * 2048 * 32;
    for (size_t i = t0; i < NI; i += nth) {
        const int ch = (int)(i & 31) * 8, r = (int)(i >> 5) & 2047, z = (int)(i >> 16), b = z >> 2, g = z & 3, k = r + 1;
        const size_t so = ((size_t)z * 2048 + r) * 256 + ch;
        f32x4 v[4][2], e[2];
#pragma unroll
        for (int p = 0; p < 4; ++p) { v[p][0] = *(const f32x4*)(CS + p * PS + so); v[p][1] = *(const f32x4*)(CS + p * PS + so + 4); }
        e[0] = *(const f32x4*)(E4 + z * 256 + ch); e[1] = *(const f32x4*)(E4 + z * 256 + ch + 4);
        const float sg = (k & 1) ? -1.0f : 1.0f;
        u32x4 o[4];
        { f32x4 a1[2], a2[2], b1[2], b2[2];
#pragma unroll
          for (int h = 0; h < 2; ++h) { const f32x4 q = e[h] * sg; a1[h] = v[0][h] + v[1][h] + q; a2[h] = v[0][h] - v[1][h] + q; b1[h] = v[2][h] + v[3][h]; b2[h] = v[3][h] - v[2][h]; }
          const f32x4 y0[2] = {a1[0] + b1[0], a1[1] + b1[1]}, y1[2] = {a1[0] - b1[0], a1[1] - b1[1]}, y2[2] = {a2[0] + b2[0], a2[1] + b2[1]}, y3[2] = {a2[0] - b2[0], a2[1] - b2[1]};
          o[0].x = cvt_pk_bf16(y0[0][0], y0[0][1]); o[0].y = cvt_pk_bf16(y0[0][2], y0[0][3]); o[0].z = cvt_pk_bf16(y0[1][0], y0[1][1]); o[0].w = cvt_pk_bf16(y0[1][2], y0[1][3]);
          o[1].x = cvt_pk_bf16(y1[0][0], y1[0][1]); o[1].y = cvt_pk_bf16(y1[0][2], y1[0][3]); o[1].z = cvt_pk_bf16(y1[1][0], y1[1][1]); o[1].w = cvt_pk_bf16(y1[1][2], y1[1][3]);
          o[2].x = cvt_pk_bf16(y2[0][0], y2[0][1]); o[2].y = cvt_pk_bf16(y2[0][2], y2[0][3]); o[2].z = cvt_pk_bf16(y2[1][0], y2[1][1]); o[2].w = cvt_pk_bf16(y2[1][2], y2[1][3]);
          o[3].x = cvt_pk_bf16(y3[0][0], y3[0][1]); o[3].y = cvt_pk_bf16(y3[0][2], y3[0][3]); o[3].z = cvt_pk_bf16(y3[1][0], y3[1][1]); o[3].w = cvt_pk_bf16(y3[1][2], y3[1][3]); }
        bf16* yb = YC + (size_t)b * SEQ * DM + 3072 + g * 256 + ch;
        *(u32x4*)(yb + (size_t)k * DM) = o[0];
        *(u32x4*)(yb + (size_t)(SEQ - k) * DM) = o[1];
        if (k < SEQ / 4) { *(u32x4*)(yb + (size_t)(SEQ / 2 - k) * DM) = o[2]; *(u32x4*)(yb + (size_t)(SEQ / 2 + k) * DM) = o[3]; }
    }
}

__device__ __forceinline__ void up_tail_rows(Frame& F, const unsigned char* __restrict__ H8, const float* __restrict__ SH, const unsigned char* __restrict__ W8, const float* __restrict__ SWl,
                                             const float* __restrict__ cw, const float* __restrict__ cb, bf16* __restrict__ U) {
    const int gw = F.wave * F.G + F.c, NGW = F.G * NWAVES, lane = F.lane;
    constexpr int R0 = TL - 5;
    u32x4 h[5][4];
#pragma unroll
    for (int r = 0; r < 5; ++r)
#pragma unroll
        for (int q = 0; q < 4; ++q) h[r][q] = *(const u32x4*)(H8 + (size_t)(R0 + r) * DM + q * 1024 + lane * 16);
    float sh[5];
#pragma unroll
    for (int r = 0; r < 5; ++r) sh[r] = SH[R0 + r];
    for (int ch = gw; ch < DFF; ch += NGW) {
        const int rg = (ch >> 7) * 256 + (ch & 127), rv = rg + 128;
        u32x4 wg[4], wv[4];
#pragma unroll
        for (int q = 0; q < 4; ++q) { wg[q] = *(const u32x4*)(W8 + (size_t)rg * DM + q * 1024 + lane * 16); wv[q] = *(const u32x4*)(W8 + (size_t)rv * DM + q * 1024 + lane * 16); }
        int ag[5] = {0, 0, 0, 0, 0}, av[4] = {0, 0, 0, 0};
#pragma unroll
        for (int q = 0; q < 4; ++q)
#pragma unroll
            for (int e = 0; e < 4; ++e) {
#pragma unroll
                for (int r = 0; r < 5; ++r) ag[r] = __builtin_amdgcn_sdot4((int)h[r][q][e], (int)wg[q][e], ag[r], false);
#pragma unroll
                for (int r = 0; r < 4; ++r) av[r] = __builtin_amdgcn_sdot4((int)h[r + 1][q][e], (int)wv[q][e], av[r], false);
            }
#pragma unroll
        for (int o = 32; o >= 1; o >>= 1) {
#pragma unroll
            for (int r = 0; r < 5; ++r) ag[r] += __shfl_xor(ag[r], o);
#pragma unroll
            for (int r = 0; r < 4; ++r) av[r] += __shfl_xor(av[r], o);
        }
        if (lane == 0) {
            const float sg = SWl[rg], sv = SWl[rv], w0 = cw[ch], w1 = cw[DFF + ch], w2 = cw[2 * DFF + ch], b = cb[ch];
            float a[5];
#pragma unroll
            for (int r = 0; r < 5; ++r) a[r] = (float)ag[r] * sh[r] * sg;
#pragma unroll
            for (int r = 0; r < 4; ++r) { const float nx = (r < 3) ? a[r + 2] : 0.f;
                const float x = w0 * a[r] + w1 * a[r + 1] + w2 * nx + b, v = (float)av[r] * sh[r + 1] * sv;
                U[(size_t)(R0 + 1 + r) * DFF + ch] = (bf16)(cvt_pk_bf16(x * sigmoidf_(x) * v, 0.f) & 0xffffu); }
        }
    }
}

__device__ __forceinline__ void merge_ctx_sum(Frame& F, const float* __restrict__ slab, bf16* __restrict__ MG) {
    const size_t nth = (size_t)F.G * NWAVES * 64, t0 = (size_t)(F.c * NWAVES + F.wave) * 64 + F.lane, NI = (size_t)TC * DM / 8;
    for (size_t i = t0; i < NI; i += nth) {
        f32x4 a0 = *(const f32x4*)(slab + i * 8), a1 = *(const f32x4*)(slab + i * 8 + 4);
        f32x4 v[7][2];
#pragma unroll
        for (int p = 1; p < 8; ++p) { v[p - 1][0] = *(const f32x4*)(slab + (size_t)p * TC * DM + i * 8); v[p - 1][1] = *(const f32x4*)(slab + (size_t)p * TC * DM + i * 8 + 4); }
#pragma unroll
        for (int p = 0; p < 7; ++p) { a0 += v[p][0]; a1 += v[p][1]; }
        u32x4 w; w.x = cvt_pk_bf16(a0[0], a0[1]); w.y = cvt_pk_bf16(a0[2], a0[3]); w.z = cvt_pk_bf16(a1[0], a1[1]); w.w = cvt_pk_bf16(a1[2], a1[3]);
        *(u32x4*)(MG + (size_t)TL * DM + i * 8) = w;
    }
}

constexpr int N_PHASES = 24;
typedef const char __attribute__((address_space(4)))* kptr_t;
__device__ __forceinline__ void make_frame(Frame& F, unsigned char* lds_raw) {
    kptr_t kp = (kptr_t)__builtin_amdgcn_kernarg_segment_ptr(); asm volatile("" : "+s"(kp));
    int tid = threadIdx.x; asm volatile("" : "+v"(tid));
    F.lds = (LAS unsigned char*)lds_raw;
    F.tid = tid; F.lane = tid & 63; F.wave = __builtin_amdgcn_readfirstlane(tid >> 6);
    F.G = gridDim.x; F.c = blockIdx.x;
#define KA(i) (*(const float* const __attribute__((address_space(4)))*)(kp + 8 * (i)))
    F.x = KA(0); F.cvec = KA(1); F.ctx = KA(2); F.c_ctx = KA(3); F.w_mod = KA(4); F.b_mod = KA(5); F.g_mix = KA(6); F.w_in = KA(7);
    F.a_sink = KA(8); F.na_rpb = KA(9); F.w_pool = KA(10); F.pool_scale = KA(11); F.w_fnet = KA(12); F.w_branch = KA(13); F.w_out = KA(14);
    F.g_ffn = KA(15); F.w_ff_gate = KA(16); F.w_ff_val = KA(17); F.ff_conv_w = KA(18); F.ff_conv_b = KA(19); F.w_ff_down = KA(20); F.g_final = KA(21);
    F.out = (float*)KA(22); F.ws = (unsigned char*)KA(23);
#undef KA
}
static_assert(WS_DFTA + (size_t)SEQ * pg8::ZK * 2 <= WS_WV8 && WS_WV8 + (size_t)2 * DFF * DM <= WS_WL, "WV8 sits behind DFTA");
static_assert(sizeof(Args) == 200, "Args layout: in[22] at 0, out at 176, ws at 184, ph_lo 192, ph_hi 196");

__global__ void __launch_bounds__(NWAVES * 64, 2) fwd(Args args) {
    extern __shared__ __attribute__((aligned(16))) unsigned char lds_raw[];
    {   LAS unsigned char* l3 = (LAS unsigned char*)lds_raw;
        for (int u = threadIdx.x; u < (LDS_BYTES - LDSCTL_OFF) / 4; u += NWAVES * 64) ((LAS unsigned*)(l3 + LDSCTL_OFF))[u] = 0u;
        __syncthreads(); }
    XcdBarrier bar; bar.bar = (unsigned*)((gu32*)(args.ws + WS_CTL) + CW_BAR); bar.x = 0; bar.st = nullptr;
    if (MK_N_LAUNCHES == 1) bar = xcd_barrier_post((unsigned*)((gu32*)(args.ws + WS_CTL) + CW_BAR), (volatile LAS unsigned*)((LAS unsigned char*)lds_raw + MISC_OFF) + 8);
    const int lo = args.ph_lo, hi = args.ph_hi;
#ifndef SITEMASK
#define SITEMASK 0xffff
#endif
#define SITE_ON(s) (((SITEMASK) >> (s)) & 1)
#ifndef MIXMASK
#define MIXMASK 7
#endif
#ifndef PROBE_DUP
#define PROBE_DUP 0
#endif
#ifndef UPV8_MASK
#define UPV8_MASK 3
#endif
#define REPS(s) (1 + (((PROBE_DUP) >> (s)) & 1))
#define IN(k) (lo <= (k) && (k) < hi)
#ifndef PROBE_BAR
#define PROBE_BAR 0
#endif
#define SEAM(k) do { if (IN(k) && IN((k) + 1)) { if (MK_N_LAUNCHES == 1) { xcd_barrier(bar); if (PROBE_BAR) { xcd_barrier(bar); xcd_barrier(bar); } } } } while (0)
#define SITE_VARS() Frame F; make_frame(F, lds_raw); unsigned char* ws = F.ws; const int G = F.G, c = F.c; (void)G; (void)c; \
    float* MOD = (float*)(ws + WS_MOD); bf16* H = (bf16*)(ws + WS_H); bf16* ACT = (bf16*)(ws + WS_ACT); bf16* MG = (bf16*)(ws + WS_MG); bf16* Gt = (bf16*)(ws + WS_G); bf16* U = (bf16*)(ws + WS_U); \
    bf16* YC = (bf16*)(ws + WS_YCAT); bf16* ZT = (bf16*)(ws + WS_ZT); bf16* ZTC = (bf16*)(ws + WS_ZTC); float* X = (float*)(ws + WS_X); \
    unsigned char* wl = ws + WS_WL + (size_t)l * WL_STRIDE; const float* modl = MOD + (size_t)l * 3 * MODW; \
    const float* xs_lat = l == 0 ? F.x : X; const float* xs_ctx = l == 0 ? F.ctx : X + (size_t)TL * DM; \
    (void)H; (void)ACT; (void)MG; (void)Gt; (void)U; (void)YC; (void)ZT; (void)ZTC; (void)X; (void)wl; (void)modl; (void)xs_lat; (void)xs_ctx;

    if (SITE_ON(0) && IN(0)) { for (int rep = 0; rep < REPS(0); ++rep) { Frame F; make_frame(F, lds_raw); phase_prologue(F, rep == 0); __syncthreads(); } }
    SEAM(0);

    for (int l = 0; l < 2; ++l) {
        const int p0 = l == 0 ? 1 : 12;
        const bool last = (l == 1);
        const int nMrows = last ? 64 : 66;

        if (SITE_ON(1) && IN(p0)) {
            { SITE_VARS(); norm_rows(F, xs_lat, xs_ctx, F.g_mix + l * DM, modl, 0, DM, H, T, l == 0 ? nullptr : (const float*)(ws + WS_SLAB), X + (size_t)TL * DM, (unsigned*)(ws + WS_H8), (float*)(ws + WS_SH), l == 0 ? (const float*)(ws + WS_PART) : nullptr, 0); }
            if (l == 0) {
                { SITE_VARS(); const float* part = (const float*)(ws + WS_PART);
                  for (int i = (c * NWAVES + F.wave) * 64 + F.lane; i < 2 * 3 * MODW; i += G * NWAVES * 64) { const int ll = i / (3 * MODW), r = i - ll * 3 * MODW, v = r / MODW, idx = r - v * MODW; MOD[i] = mod_from_parts(part, ll, v, idx); } }
                { Frame F; make_frame(F, lds_raw); quant_gate_weights(F); }
                __syncthreads();
                { SITE_VARS(); pg8::SchedJob S; S.A = (const char*)(ws + WS_WB3T); S.B = (const char*)(ws + WS_WFNETB); S.nZ2 = 1; S.nM = 16; S.nN = 4; S.nTot = 2 * 64; S.hbB = 128L * 1024 * 2;
                  S.az1 = (size_t)DM * 1024 * 2; S.az2 = 0; S.am = (size_t)256 * 1024 * 2; S.bz1 = (size_t)1024 * 1024 * 2; S.bz2 = 0; S.bn = (size_t)256 * 1024 * 2;
                  S.oz1 = (long)(WL_STRIDE / 2); S.oz2 = 0; S.om = (long)256 * DM; S.on = 256;
                  pg8::EpiStore E{(bf16*)(ws + WS_WL + WL_M) + 3072, DM};
                  pg8::gemm_phase<pg8::EpiStore, pg8::SchedJob, true>(F.lds, 1024, 1024, 1024, S, E, G, c); }
                __syncthreads();
                { SITE_VARS(); pg8::SchedJob S; S.A = (const char*)(ws + WS_WB2ST); S.B = (const char*)(ws + WS_WPOOLB); S.nZ2 = 4; S.nM = 16; S.nN = 1; S.nTot = 8 * 16; S.hbB = 128L * 256 * 2;
                  S.az1 = (size_t)DM * 1024 * 2; S.az2 = 256 * 2; S.am = (size_t)256 * 1024 * 2; S.bz1 = (size_t)4 * 65536 * 2; S.bz2 = (size_t)65536 * 2; S.bn = 0;
                  S.oz1 = (long)(WL_STRIDE / 2); S.oz2 = 256; S.om = (long)256 * DM; S.on = 0;
                  pg8::EpiStore E{(bf16*)(ws + WS_WL + WL_M) + 2048, DM};
                  pg8::gemm_phase<pg8::EpiStore, pg8::SchedJob, true>(F.lds, 256, 1024, 256, S, E, G, c); }
            }
        }
        SEAM(p0);

        if (SITE_ON(2) && IN(p0 + 1)) for (int rep = 0; rep < REPS(2); ++rep) {
            SITE_VARS();
            { pg8::SchedRect S; S.A = (const char*)H; S.B = (const char*)(wl + WL_IN); S.nM = last ? 64 : 66; S.nN = 26; S.aS = (size_t)256 * DM * 2; S.bS = (size_t)256 * DM * 2; S.extra = last ? 20 : 0; S.t_c0 = 0; S.t_g = 0;
              pg8::EpiIn E{ACT, Gt, (const float*)(ws + WS_ROPE)};
              pg8::gemm_phase<pg8::EpiIn, pg8::SchedRect, true>(F.lds, DM, DM, DM, S, E, G, c); }
            __syncthreads();
            { SITE_VARS();
              pg8::SchedRect S; S.A = (const char*)(ws + WS_H8); S.B = (const char*)(ws + WS_WG8 + (size_t)l * 16384 * DM); S.nM = last ? 64 : 66; S.nN = 64; S.aS = (size_t)256 * DM; S.bS = (size_t)256 * DM; S.extra = 0; S.t_c0 = 184; S.t_g = (!last && G == 256) ? 72 : 0;
              pg8::EpiGate E{Gt, (const float*)(ws + WS_SH), (const float*)(ws + WS_SW) + l * 16384};
              pg8::gemm_phase<pg8::EpiGate, pg8::SchedRect, true>(F.lds, DM / 2, DM / 2, DM / 2, S, E, G, c); }
        }
        SEAM(p0 + 1);

        if (SITE_ON(3) && IN(p0 + 2)) for (int rep = 0; rep < REPS(3); ++rep) {
            if (MIXMASK & 1) { SITE_VARS(); pg8::SchedS1 S; S.A = (const char*)(ws + WS_TAB1); S.Ub = (const char*)(ACT + OFF_FU);
              pg8::EpiS1 E{ZT};
              pg8::gemm_phase<pg8::EpiS1, pg8::SchedS1, true>(F.lds, 256, 256, ACTW, S, E, G, c); }
            if ((MIXMASK & 1) && !last) { __syncthreads();
              SITE_VARS(); pg8::SchedJob S; S.A = (const char*)(ws + WS_TAB1); S.B = (const char*)(ACT + (size_t)TL * ACTW + OFF_FU); S.nZ2 = 4; S.nM = 2; S.nN = 1; S.nTot = 8 * 2; S.hbB = 128L * ACTW * 2;
              S.az1 = 0; S.az2 = 0; S.am = (size_t)256 * 256 * 2; S.bz1 = (size_t)CTXL * ACTW * 2; S.bz2 = 256 * 2; S.bn = 0;
              S.oz1 = (long)4 * 256 * 512; S.oz2 = (long)256 * 512; S.om = 256; S.on = 0;
              pg8::EpiStore E{ZTC, 512};
              pg8::gemm_phase<pg8::EpiStore, pg8::SchedJob, true>(F.lds, 256, 256, ACTW, S, E, G, G == 256 ? ((c + 192) & 255) : c); }
            __syncthreads();
            if (MIXMASK & 2) { SITE_VARS(); const int NU = last ? 1024 : 1056;
              for (int it = 0; ; ++it) {
                  int L = it * G + c;
                  if (G == 256 && it == 4) L = (c >= 128 && c < 160) ? 1024 + c - 128 : NU;
                  if (L >= NU) break;
                  int kind, b, hh, blk;
                  if (L < 512) { kind = 1; b = L >> 8; hh = (L >> 5) & 7; blk = L & 31; }
                  else if (L < 1024) { const int i = L - 512; kind = 0; b = i >> 8; hh = (i >> 7) & 1; blk = i & 127; }
                  else if (L < 1040) { const int i = L - 1024; kind = 2; b = i >> 3; hh = (i >> 2) & 1; blk = i & 3; }
                  else { const int i = L - 1040; kind = 3; b = i >> 3; hh = i & 7; blk = 0; }
                  att::attn_unit((LAS char*)F.lds, ACT, YC, F.a_sink + l * 8, F.na_rpb + (size_t)l * 8 * 465, kind, b, hh, blk);
              } }
            if (MIXMASK & 4) { SITE_VARS(); pool_diff(F, ACT, YC, last ? TL : T); }
        }
        SEAM(p0 + 2);

        if (SITE_ON(4) && IN(p0 + 3)) for (int rep = 0; rep < REPS(4); ++rep) {
            { SITE_VARS(); pg8::SchedDft S; S.A = (const char*)(ws + WS_DFTA); S.B = (const char*)ZT;
              pg8::EpiF32 E{(float*)(ws + WS_H)};
              pg8::gemm_phase<pg8::EpiF32, pg8::SchedDft, true>(F.lds, pg8::ZK, pg8::ZK, pg8::ZK, S, E, G, c); }
            { SITE_VARS(); dft_specials(F, ZT, YC, (float*)(ws + WS_H + 64 * MiB), ACT, (const bf16*)(ws + WS_TAB1)); }
            if (!last) { __syncthreads();
              SITE_VARS(); pg8::SchedJob S; S.A = (const char*)(ws + WS_DFTC); S.B = (const char*)ZTC; S.nZ2 = 4; S.nM = 1; S.nN = 1; S.nTot = 8; S.hbB = 128L * 512 * 2;
              S.az1 = 0; S.az2 = 0; S.am = 0; S.bz1 = (size_t)4 * 256 * 512 * 2; S.bz2 = (size_t)256 * 512 * 2; S.bn = 0;
              S.oz1 = (long)CTXL * DM; S.oz2 = 256; S.om = 0; S.on = 0;
              pg8::EpiStore E{YC + (size_t)TL * DM + 3072, DM};
              pg8::gemm_phase<pg8::EpiStore, pg8::SchedJob, true>(F.lds, 512, 512, 512, S, E, G, c); }
        }
        SEAM(p0 + 3);

        if (SITE_ON(11) && IN(p0 + 4)) { SITE_VARS(); dft_combine(F, (const float*)(ws + WS_H), (const float*)(ws + WS_H + 64 * MiB), YC); }
        SEAM(p0 + 4);

        if (SITE_ON(5) && IN(p0 + 5)) for (int rep = 0; rep < REPS(5); ++rep) {
            SITE_VARS();
            pg8::SchedSplit S; S.A = (const char*)YC; S.B = (const char*)(wl + WL_M); S.aS = (size_t)256 * DM * 2; S.bS = (size_t)256 * DM * 2; S.pairs = DM / 128; S.nctx = last ? 0 : 256;
            pg8::EpiMerge E{Gt, MG, (float*)(ws + WS_SLAB)};
            pg8::gemm_phase<pg8::EpiMerge, pg8::SchedSplit, true>(F.lds, DM, DM, DM, S, E, G, c);
        }
        SEAM(p0 + 5);

        if (SITE_ON(12) && IN(p0 + 6) && !last) { SITE_VARS(); merge_ctx_sum(F, (const float*)(ws + WS_SLAB), MG); }
        SEAM(p0 + 6);

        if (SITE_ON(6) && IN(p0 + 7)) for (int rep = 0; rep < REPS(6); ++rep) {
            SITE_VARS();
            pg8::SchedSplit S; S.A = (const char*)MG; S.B = (const char*)(wl + WL_OUT); S.aS = (size_t)256 * DM * 2; S.bS = (size_t)256 * DM * 2; S.pairs = DM / 128; S.nctx = last ? 0 : 256;
            pg8::EpiResid E{xs_lat, xs_ctx, (rep + 1 < REPS(6)) ? (float*)(ws + 2800 * MiB) : X, modl + 2 * DM, (float*)(ws + WS_SLAB)};
            pg8::gemm_phase<pg8::EpiResid, pg8::SchedSplit, true>(F.lds, DM, DM, DM, S, E, G, c);
        }
        SEAM(p0 + 7);

        if (SITE_ON(7) && IN(p0 + 8)) for (int rep = 0; rep < REPS(7); ++rep) { SITE_VARS(); norm_rows(F, X, X + (size_t)TL * DM, F.g_ffn + l * DM, modl, 3 * DM, 4 * DM, nullptr, last ? TL : T, last ? nullptr : (const float*)(ws + WS_SLAB), X + (size_t)TL * DM, (unsigned*)(ws + WS_H8), (float*)(ws + WS_SH)); }
        SEAM(p0 + 8);

        if (SITE_ON(8) && IN(p0 + 9)) for (int rep = 0; rep < REPS(8); ++rep) {
            SITE_VARS();
            if (last && rep == 0) { up_tail_rows(F, ws + WS_H8, (const float*)(ws + WS_SH), ws + WS_WGA8, (const float*)(ws + WS_SWUP) + (size_t)l * NUP, F.ff_conv_w + (size_t)l * 3 * DFF, F.ff_conv_b + (size_t)l * DFF, U); }
            pg8::SchedUp S; S.A = (const char*)(ws + WS_H8) - (size_t)DM; S.B = (const char*)(ws + (l == 0 ? WS_WV8 : WS_WGA8)); S.nM = last ? 65 : 68; S.nN = 86; S.aS = (size_t)252 * DM; S.bS = (size_t)256 * DM;
            pg8::EpiUp8 E{U, F.ff_conv_w + (size_t)l * 3 * DFF, F.ff_conv_b + (size_t)l * DFF, (const float*)(ws + WS_SH), (const float*)(ws + WS_SWUP) + (size_t)l * NUP};
            pg8::gemm_phase<pg8::EpiUp8, pg8::SchedUp, true>(F.lds, DM / 2, DM / 2, DM / 2, S, E, G, c);
        }
        SEAM(p0 + 9);

        if (SITE_ON(9) && IN(p0 + 10)) for (int rep = 0; rep < REPS(9); ++rep) {
            SITE_VARS();
            pg8::SchedSplit S; S.A = (const char*)U; S.B = (const char*)(wl + WL_DN); S.aS = (size_t)256 * DFF * 2; S.bS = (size_t)256 * DFF * 2; S.pairs = DFF / 128; S.nctx = last ? 0 : 256;
            pg8::EpiResid E{X, X + (size_t)TL * DM, (rep + 1 < REPS(9)) ? (float*)(ws + 2800 * MiB) : X, modl + 5 * DM, (float*)(ws + WS_SLAB)};
            pg8::gemm_phase<pg8::EpiResid, pg8::SchedSplit, true>(F.lds, DFF, DFF, DFF, S, E, G, c);
        }
        SEAM(p0 + 10);
    }
    if (SITE_ON(10) && IN(23)) { const int l = 1; SITE_VARS(); final_norm(F, X); }
#undef IN
#undef SEAM
}


#ifdef DBG_STOP
__global__ void dbg_dump(const unsigned char* ws, size_t off, int isf32, float* out) {
    const size_t n = (size_t)TL * DM;
    for (size_t i = (size_t)blockIdx.x * blockDim.x + threadIdx.x; i < n; i += (size_t)gridDim.x * blockDim.x)
        out[i] = isf32 ? ((const float*)(ws + off))[i] : bf2f(((const unsigned short*)(ws + off))[i]);
}
#endif
extern "C" void kernel_launch(void* const* d_in, const int* in_sizes, int n_in, void* d_out, int out_size, void* d_ws, size_t ws_size, hipStream_t stream) {
    static int grid = 0;
    if (grid == 0) {
        if (n_in != 22 || ws_size < WS_END) { fprintf(stderr, "kernel_launch: n_in %d ws %zu (need %zu)\n", n_in, ws_size, (size_t)WS_END); grid = -1; return; }
        int dev = 0, cus = 0;
        if (hipGetDevice(&dev) != hipSuccess || hipDeviceGetAttribute(&cus, hipDeviceAttributeMultiprocessorCount, dev) != hipSuccess) { grid = -1; return; }
        if (hipFuncSetAttribute((const void*)fwd, hipFuncAttributeMaxDynamicSharedMemorySize, LDS_BYTES) != hipSuccess) { fprintf(stderr, "kernel_launch: hipFuncSetAttribute failed\n"); grid = -1; return; }
        int per_cu = 0; (void)hipOccupancyMaxActiveBlocksPerMultiprocessor(&per_cu, (const void*)fwd, NWAVES * 64, LDS_BYTES); (void)hipGetLastError();
        grid = cus;
    }
    if (grid < 0) return;
    (void)hipMemsetAsync((char*)d_ws + WS_CTL, 0, CTL_ZERO_BYTES, stream);
    Args a{};
    for (int i = 0; i < 22; ++i) a.in[i] = (const float*)d_in[i];
    a.out = (float*)d_out; a.ws = (unsigned char*)d_ws;
#ifdef DBG_STOP
    for (int p = 0; p < DBG_STOP; ++p) { a.ph_lo = p; a.ph_hi = p + 1; hipLaunchKernelGGL(fwd, dim3(grid), dim3(NWAVES * 64), LDS_BYTES, stream, a); }
    hipLaunchKernelGGL(dbg_dump, dim3(2048), dim3(256), 0, stream, (const unsigned char*)d_ws, (size_t)DBG_OFF, (int)DBG_F32, (float*)d_out);
    return;
#endif
    if (MK_N_LAUNCHES == 1) { a.ph_lo = 0; a.ph_hi = N_PHASES; hipLaunchKernelGGL(fwd, dim3(grid), dim3(NWAVES * 64), LDS_BYTES, stream, a); }
    else { for (int p = 0; p < N_PHASES; ++p) { a.ph_lo = p; a.ph_hi = p + 1; hipLaunchKernelGGL(fwd, dim3(grid), dim3(NWAVES * 64), LDS_BYTES, stream, a); } }
}
```

```cpp
#include <hip/hip_runtime.h>
#include <cstdio>
#include <cstdint>

#ifndef MK_N_LAUNCHES
#define MK_N_LAUNCHES 1
#endif

#define GAS __attribute__((address_space(1)))
#define LAS __attribute__((address_space(3)))
typedef unsigned short bf16;
typedef short bf16x8 __attribute__((ext_vector_type(8)));
typedef short s16x4 __attribute__((ext_vector_type(4)));
typedef float f32x4 __attribute__((ext_vector_type(4)));
typedef float f32x2 __attribute__((ext_vector_type(2)));
typedef float f32x16 __attribute__((ext_vector_type(16)));
typedef unsigned u32x4 __attribute__((ext_vector_type(4)));
typedef unsigned u32x2 __attribute__((ext_vector_type(2)));
typedef int i32x4 __attribute__((ext_vector_type(4)));
typedef GAS unsigned gu32;

constexpr int DM = 4096, SEQ = 8192, NBATCH = 2, CTXL = 256;
constexpr int TL = NBATCH * SEQ;
constexpr int TC = NBATCH * CTXL;
constexpr int T = TL + TC;
constexpr int NIN = 23040, DFF = 11008, NUP = 2 * DFF, ACTW = 6656, GW = 16384;
constexpr int OFF_AQ = 0, OFF_AK = 1024, OFF_AV = 1280, OFF_NQ = 1536, OFF_NK = 2560, OFF_NV = 3584, OFF_PU = 4608, OFF_FU = 5632;
constexpr int MODW = 6 * DM;
constexpr float QSCALE = 0.08838834764831845f * 1.4426950408889634f;
constexpr float LOG2E = 1.4426950408889634f;
constexpr float EPS = 1e-6f;

constexpr size_t MiB = 1u << 20;
constexpr size_t WS_CTL = 0, CTL_ZERO_BYTES = 2 * MiB;
constexpr size_t WS_MOD = 1 * MiB;
constexpr size_t WS_CM3 = 1 * MiB + 896 * 1024;
constexpr size_t WS_CM2 = 1 * MiB + 768 * 1024;
constexpr size_t WS_CM = 1 * MiB + 640 * 1024;
constexpr size_t WS_ROPE = 2 * MiB;
constexpr size_t WS_TAB1 = 2 * MiB + 256 * 1024;
constexpr size_t WS_DFTC = 2 * MiB + 512 * 1024;
constexpr size_t WS_WPOOLB = 3 * MiB;
constexpr size_t WS_WFNETB = 4 * MiB;
constexpr size_t WS_WB2ST = 8 * MiB;
constexpr size_t WS_WB3T = 24 * MiB;
constexpr size_t WS_DFTA = 40 * MiB;
constexpr size_t WS_WL = 296 * MiB, WL_STRIDE = 504 * MiB;
constexpr size_t WL_IN = 0, WL_M = 180 * MiB, WL_OUT = 212 * MiB, WL_UP = 244 * MiB, WL_DN = 416 * MiB;
constexpr size_t WS_H = 1306 * MiB;
constexpr size_t WS_ACT = 1440 * MiB;
constexpr size_t WS_MG = WS_ACT;
constexpr size_t WS_G = 1656 * MiB;
constexpr size_t WS_U = WS_G;
constexpr size_t WS_YCAT = 2184 * MiB;
constexpr size_t WS_ZT = 2316 * MiB;
constexpr size_t WS_ZTC = 2380 * MiB;
constexpr size_t WS_X = 2382 * MiB;
constexpr size_t WS_SLAB = 2648 * MiB;
constexpr size_t WS_H8 = 2712 * MiB;
constexpr size_t WS_WG8 = 2780 * MiB;
constexpr size_t WS_SH = 2908 * MiB;
constexpr size_t WS_SW = 2908 * MiB + 256 * 1024;
constexpr size_t WS_WGA8 = 2910 * MiB;
constexpr size_t WS_SWG = 2908 * MiB + 512 * 1024;
constexpr size_t WS_WV8 = 172 * MiB;
constexpr size_t WS_SWUP = 2908 * MiB + 768 * 1024;
constexpr size_t WS_SWV = 2908 * MiB + 640 * 1024;
constexpr size_t WS_PART = 2998 * MiB;
constexpr size_t WS_END = 3008 * MiB;

constexpr int CW_TMO = 0;
constexpr int CW_BAR = 4096;

constexpr int RING_BYTES = 131072;
constexpr int LDSCTL_OFF = RING_BYTES, MISC_OFF = LDSCTL_OFF + 320;
constexpr int LDS_BYTES = 147456;
constexpr int NWAVES = 8;

#define RLX_AGENT __ATOMIC_RELAXED, __HIP_MEMORY_SCOPE_AGENT
#define LDS_WAIT() asm volatile("s_waitcnt lgkmcnt(0)" ::: "memory")
#define VM_WAIT() asm volatile("s_waitcnt vmcnt(0)" ::: "memory")
typedef __bf16 bf16x2_t __attribute__((ext_vector_type(2)));
__device__ __forceinline__ unsigned cvt_pk_bf16(float lo, float hi) { f32x2 f = {lo, hi}; bf16x2_t v = __builtin_convertvector(f, bf16x2_t); return __builtin_bit_cast(unsigned, v); }
__device__ __forceinline__ float bf2f(unsigned short b) { return __builtin_bit_cast(float, ((unsigned)b) << 16); }
__device__ __forceinline__ float bflo(unsigned w) { return __builtin_bit_cast(float, w << 16); }
__device__ __forceinline__ float bfhi(unsigned w) { return __builtin_bit_cast(float, w & 0xffff0000u); }
__device__ __forceinline__ float fast_exp2(float x) { return __builtin_amdgcn_exp2f(x); }
__device__ __forceinline__ float fast_rcp(float x) { return __builtin_amdgcn_rcpf(x); }
__device__ __forceinline__ float sigmoidf_(float x) { return fast_rcp(1.0f + fast_exp2(-x * LOG2E)); }
__device__ __forceinline__ float wave_sum(float v) {
#pragma unroll
    for (int o = 1; o < 64; o <<= 1) v += __shfl_xor(v, o);
    return v;
}

#define XB_TMO      128
#define XB_XCNT(j)  (256  + 64 * (j))
#define XB_XSUB(j)  (1280 + 64 * (j))
#define XB_XGEN(j)  (2304 + 64 * (j))
#define XB_TOP      3328
#define XB_TOPGEN   3392
#define XCD_BAR_WORDS 3456
#define XB_SPIN_CAP (1u << 18)
__device__ __forceinline__ unsigned xb_ld(unsigned* p)              { return __hip_atomic_load(p, __ATOMIC_RELAXED, __HIP_MEMORY_SCOPE_AGENT); }
__device__ __forceinline__ unsigned xb_add(unsigned* p, unsigned v) { return __hip_atomic_fetch_add(p, v, __ATOMIC_RELAXED, __HIP_MEMORY_SCOPE_AGENT); }
__device__ __forceinline__ unsigned xb_xcc_id() { return (unsigned)__builtin_amdgcn_s_getreg((3 << 11) | 20) & 0xFu; }
#define XB_SPIN(cond, bar) do { unsigned _sp = 0; while (cond) { __builtin_amdgcn_s_sleep(1); \
    if ((++_sp & 255u) == 0u) { if (xb_ld(&(bar)[XB_TMO])) break; if (_sp > XB_SPIN_CAP) { atomicAdd(&(bar)[XB_TMO], 1u); break; } } } } while (0)
struct XcdBarrier { unsigned* bar; unsigned x; volatile LAS unsigned* st; };
__device__ __forceinline__ XcdBarrier xcd_barrier_post(unsigned* bar, volatile LAS unsigned* st) {
    XcdBarrier b; b.bar = bar; b.x = xb_xcc_id(); b.st = st;
    if (threadIdx.x == 0) (void)xb_add(&bar[XB_XCNT(b.x)], 1u);
    return b;
}
__device__ __forceinline__ void xcd_barrier_complete(unsigned* bar, unsigned x, unsigned& nloc, unsigned& nx) {
    const unsigned G = gridDim.x * gridDim.y * gridDim.z;
    unsigned sum, cnt, mine, sp = 0u;
    for (;;) {
        sum = 0u; cnt = 0u; mine = 0u;
#pragma unroll 1
        for (unsigned j = 0; j < 16; ++j) { const unsigned c = xb_ld(&bar[XB_XCNT(j)]); sum += c; cnt += (c > 0u) ? 1u : 0u; mine = (j == x) ? c : mine; }
        if (sum == G) break;
        __builtin_amdgcn_s_sleep(1);
        if ((++sp & 255u) == 0u) { if (xb_ld(&bar[XB_TMO])) break; if (sp > XB_SPIN_CAP) { atomicAdd(&bar[XB_TMO], 1u); break; } }
    }
    nloc = mine > 0u ? mine : 1u; nx = cnt > 0u ? cnt : 1u;
}
__device__ __forceinline__ void xcd_barrier(const XcdBarrier& b) {
    asm volatile("s_waitcnt vmcnt(0)" ::: "memory");
    __syncthreads();
    if (threadIdx.x == 0) {
        unsigned* bar = b.bar;
        __builtin_amdgcn_s_waitcnt(0);
        unsigned nloc = b.st[0], nx = b.st[1];
        if (nloc == 0u) { xcd_barrier_complete(bar, b.x, nloc, nx); b.st[0] = nloc; b.st[1] = nx; }
        const unsigned old = xb_add(&bar[XB_XSUB(b.x)], 1u);
        const unsigned gen = old / nloc;
        if (old + 1u == (gen + 1u) * nloc) {
            __builtin_amdgcn_fence(__ATOMIC_RELEASE, "agent");
            asm volatile("s_waitcnt vmcnt(0)" ::: "memory");
            const unsigned og = xb_add(&bar[XB_TOP], 1u);
            const unsigned tg = og / nx;
            if (og + 1u == (tg + 1u) * nx) xb_add(&bar[XB_TOPGEN], 1u);
            else XB_SPIN(xb_ld(&bar[XB_TOPGEN]) == tg, bar);
            __builtin_amdgcn_fence(__ATOMIC_ACQUIRE, "agent");
            xb_add(&bar[XB_XGEN(b.x)], 1u);
            asm volatile("s_waitcnt vmcnt(0)" ::: "memory");
        } else {
            XB_SPIN(xb_ld(&bar[XB_XGEN(b.x)]) == gen, bar);
            __builtin_amdgcn_fence(__ATOMIC_ACQUIRE, "agent");
            asm volatile("s_waitcnt vmcnt(0)" ::: "memory");
        }
    }
    __syncthreads();
}

namespace pg8 {
constexpr int BM = 256, BK = 64, HALF = 128, HTB = HALF * BK * 2, STAGE_BYTES = 8 * HTB;
__host__ __device__ __forceinline__ int lds_byte(int r, int c) { const int st = (r >> 4) * 2 + (c >> 5), rr = r & 15, cc = c & 31, ob = rr * 64 + cc * 2; return st * 1024 + (ob ^ (((ob >> 9) & 1) << 5)); }
__host__ __device__ __forceinline__ void stage_rc(int b, int& R, int& C) { const int st = b / 1024, sb = b % 1024, swz = sb ^ (((sb >> 9) & 1) << 5); R = (st >> 1) * 16 + swz / 64; C = (st & 1) * 32 + (swz % 64) / 2; }
__host__ __device__ __forceinline__ int perm32(int rho) { const int n = rho >> 4, i = rho & 15; return 8 * (i >> 2) + 4 * n + (i & 3); }
__host__ __device__ __forceinline__ int perm32p(int rho) { const int n = rho >> 4, i = rho & 15, q = i >> 2; return 16 * (q & 1) + 2 * (4 * n + (i & 3)) + (q >> 1); }
struct EpiS1;
template <class E> struct PermKind { static constexpr int v = E::PERM ? 1 : 0; };
template <> struct PermKind<EpiS1> { static constexpr int v = 2; };

struct Unit { int pm, pn; const char* pa; const char* pb; long oo; long hb; int nt; };

__device__ __forceinline__ void tile_order(int L, int nM, int nN, int& pm, int& pn) {
    const int nwg = nM * nN; int wgid = L;
    { const int q = nwg / 8, r = nwg % 8, xcd = wgid % 8, off = wgid / 8; wgid = (xcd < r ? xcd * (q + 1) : r * (q + 1) + (xcd - r) * q) + off; }
    const int nig = 8 * nN, gid = wgid / nig, fm = gid * 8, gsz = (nM - fm) < 8 ? (nM - fm) : 8;
    pm = fm + ((wgid % nig) % gsz); pn = (wgid % nig) / gsz;
}

template <class Epi, class Sched, bool ALIGN_EPI>
__device__ __forceinline__ void gemm_phase(LAS unsigned char* lds, const int K, const int lda, const int ldb, const Sched& S, const Epi& E, const int G, const int c) {
    int tid_ = threadIdx.x; asm volatile("" : "+v"(tid_));
    const int tid = tid_, wid = __builtin_amdgcn_readfirstlane(tid >> 6), lane = tid & 63, wr = wid >> 2, wc = wid & 3, fr = lane & 15, fq = lane >> 4;
    const int nt_full = K / BK;
    int voffA[2], voffB[2], voffB1[2];
#pragma unroll
    for (int i = 0; i < 2; ++i) { int R, C; stage_rc(tid * 16 + i * 8192, R, C); const int Rb = PermKind<Epi>::v == 2 ? ((R & ~31) + perm32p(R & 31)) : PermKind<Epi>::v == 1 ? ((R & ~31) + perm32(R & 31)) : R;
        voffA[i] = (Sched::a_row(R) * lda + C) * 2; voffB[i] = (Rb * ldb + C) * 2; voffB1[i] = Sched::B_MIRROR ? (-Rb * ldb + C) * 2 : voffB[i]; }
    const size_t kstep = (size_t)(BK * 2);
    const size_t hstepA = (size_t)Sched::A_HROWS * lda * 2;
    const unsigned ldsw = (unsigned)wid * 1024u;
    const int aoff = lds_byte(wr * 64 + fr, fq * 8), boff = lds_byte(wc * 32 + fr, fq * 8);
#define PG8_SA(b, h) (((b) * 2 + (h)) * HTB)
#define PG8_SB(b, h) ((4 + (b) * 2 + (h)) * HTB)
#define PG8_STAGE(bufoff, gbase, voff) do { _Pragma("unroll") for (int _i = 0; _i < 2; ++_i) \
        __builtin_amdgcn_global_load_lds((const unsigned*)((const char*)(gbase) + (long)(voff)[_i]), (LAS unsigned*)(lds + (bufoff) + ldsw + _i * 8192), 16, 0, 0); } while (0)
#define PG8_LDA(dst, b, h) do { _Pragma("unroll") for (int m = 0; m < 4; ++m) _Pragma("unroll") for (int k = 0; k < 2; ++k) dst[m][k] = *(const LAS bf16x8*)(lds + PG8_SA(b, h) + aoff + m * 2048 + k * 1024); } while (0)
#define PG8_LDB(dst, b, h) do { _Pragma("unroll") for (int n = 0; n < 2; ++n) _Pragma("unroll") for (int k = 0; k < 2; ++k) dst[n][k] = *(const LAS bf16x8*)(lds + PG8_SB(b, h) + boff + n * 2048 + k * 1024); } while (0)
#define PG8_MMA(ai, bj, At, Bt) do { __builtin_amdgcn_s_setprio(1); _Pragma("unroll") for (int m = 0; m < 4; ++m) _Pragma("unroll") for (int n = 0; n < 2; ++n) _Pragma("unroll") for (int k = 0; k < 2; ++k) { \
        if constexpr (Epi::I8) acc[ai][bj][m][n] = __builtin_bit_cast(f32x4, __builtin_amdgcn_mfma_i32_16x16x64_i8(__builtin_bit_cast(i32x4, Bt[n][k]), __builtin_bit_cast(i32x4, At[m][k]), __builtin_bit_cast(i32x4, acc[ai][bj][m][n]), 0, 0, 0)); \
        else acc[ai][bj][m][n] = __builtin_amdgcn_mfma_f32_16x16x32_bf16(Bt[n][k], At[m][k], acc[ai][bj][m][n], 0, 0, 0); } __builtin_amdgcn_s_setprio(0); } while (0)
#define PG8_WAIT_V(n) asm volatile("s_waitcnt vmcnt(" #n ")" ::: "memory")
#define PG8_WAIT_L(n) asm volatile("s_waitcnt lgkmcnt(" #n ")" ::: "memory")
#define PG8_BAR __builtin_amdgcn_s_barrier()
#define PG8_SCHED __builtin_amdgcn_sched_barrier(0)
    Unit cur, nxt; int ui = 0;
    { const long L = S.unit(0, c, G); if (L >= S.total()) return; S.decode((int)L, cur); asm volatile("" : "+s"(cur.pa), "+s"(cur.pb)); }
    f32x4 acc[2][2][4][2];
#pragma unroll
    for (int a = 0; a < 2; ++a)
#pragma unroll
        for (int b = 0; b < 2; ++b)
#pragma unroll
            for (int m = 0; m < 4; ++m)
#pragma unroll
                for (int n = 0; n < 2; ++n) acc[a][b][m][n] = (f32x4){0.f, 0.f, 0.f, 0.f};
    bf16x8 At[4][2], B0[2][2], B1[2][2];
    const char* cA = cur.pa; const char* cB = cur.pb;
    long cHB = cur.hb;
    PG8_STAGE(PG8_SB(0, 0), cB, voffB); PG8_STAGE(PG8_SB(0, 1), cB + cHB, voffB1); PG8_STAGE(PG8_SA(0, 0), cA, voffA); PG8_STAGE(PG8_SA(0, 1), cA + hstepA, voffA);
    if (wr == 1) PG8_BAR;
    PG8_WAIT_V(2); PG8_BAR;
    PG8_STAGE(PG8_SB(1, 0), cB + kstep, voffB); PG8_STAGE(PG8_SA(1, 0), cA + kstep, voffA); PG8_STAGE(PG8_SB(1, 1), cB + cHB + kstep, voffB1);
    PG8_WAIT_V(6); PG8_BAR;
    for (;;) {
        bool has_next; { const long L = S.unit(ui + 1, c, G); has_next = L < S.total(); if (has_next) { S.decode((int)L, nxt); asm volatile("" : "+s"(nxt.pa), "+s"(nxt.pb)); } }
        const char* nA = has_next ? nxt.pa : cA; const char* nB = has_next ? nxt.pb : cB; const long nHB = has_next ? nxt.hb : cHB;
        const int nt = Sched::SPLITK ? cur.nt : nt_full;
#pragma clang loop unroll(disable)
        for (int t = 0; t < nt; t += 2) {
            const bool last = (t == nt - 2);
            const char* a1 = cA + (size_t)(t + 1) * kstep;
            const char* a2 = last ? nA : cA + (size_t)(t + 2) * kstep; const char* b2 = last ? nB : cB + (size_t)(t + 2) * kstep;
            const char* a3 = a2 + kstep; const char* b3 = b2 + kstep; const long hB2 = last ? nHB : cHB;
            if constexpr (Epi::HOOK_TILES > 0) { if (t != 0 && (t % Epi::HOOK_TILES) == 0) E.hook(acc, cur, t / Epi::HOOK_TILES, wr, wc, fr, fq); }
            PG8_LDB(B0, 0, 0); PG8_LDB(B1, 0, 1); PG8_SCHED; PG8_LDA(At, 0, 0); PG8_STAGE(PG8_SA(1, 1), a1 + hstepA, voffA);
            PG8_WAIT_V(8); PG8_WAIT_L(0); PG8_BAR; PG8_MMA(0, 0, At, B0); PG8_MMA(0, 1, At, B1); PG8_BAR; PG8_SCHED;
            PG8_LDA(At, 0, 1); PG8_STAGE(PG8_SB(0, 0), b2, voffB); PG8_STAGE(PG8_SB(0, 1), b2 + hB2, voffB1); PG8_STAGE(PG8_SA(0, 0), a2, voffA);
            PG8_WAIT_V(8); PG8_WAIT_L(0); PG8_BAR; PG8_MMA(1, 0, At, B0); PG8_MMA(1, 1, At, B1); PG8_BAR; PG8_SCHED;
            PG8_LDB(B0, 1, 0); PG8_LDB(B1, 1, 1); PG8_SCHED; PG8_LDA(At, 1, 0); PG8_STAGE(PG8_SA(0, 1), a2 + hstepA, voffA);
            PG8_WAIT_V(8); PG8_WAIT_L(0); PG8_BAR; PG8_MMA(0, 0, At, B0); PG8_MMA(0, 1, At, B1); PG8_BAR; PG8_SCHED;
            PG8_LDA(At, 1, 1); PG8_STAGE(PG8_SB(1, 0), b3, voffB); PG8_STAGE(PG8_SB(1, 1), b3 + hB2, voffB1); PG8_STAGE(PG8_SA(1, 0), a3, voffA);
            PG8_WAIT_V(8); PG8_WAIT_L(0); PG8_BAR; PG8_MMA(1, 0, At, B0); PG8_MMA(1, 1, At, B1); PG8_BAR; PG8_SCHED;
        }
        if constexpr (ALIGN_EPI) { if (wr == 0) PG8_BAR; }
        E(acc, cur, wr, wc, fr, fq);
        if (!has_next) break;
#pragma unroll
        for (int a = 0; a < 2; ++a)
#pragma unroll
            for (int b = 0; b < 2; ++b)
#pragma unroll
                for (int m = 0; m < 4; ++m)
#pragma unroll
                    for (int n = 0; n < 2; ++n) acc[a][b][m][n] = (f32x4){0.f, 0.f, 0.f, 0.f};
        cur = nxt; cA = nA; cB = nB; cHB = nHB; ++ui;
        if constexpr (ALIGN_EPI) { if (wr == 1) PG8_BAR; }
    }
    PG8_WAIT_V(0);
    if constexpr (!ALIGN_EPI) { if (wr == 0) PG8_BAR; }
    PG8_BAR;
#undef PG8_SA
#undef PG8_SB
#undef PG8_STAGE
#undef PG8_LDA
#undef PG8_LDB
#undef PG8_MMA
#undef PG8_WAIT_V
#undef PG8_WAIT_L
#undef PG8_BAR
#undef PG8_SCHED
}

struct SchedRect {
    const char* A; const char* B; int nM, nN; size_t aS, bS; int extra; int t_c0, t_g;
    static __device__ __forceinline__ int a_row(int R) { return R; }
    static constexpr int A_HROWS = 128; static constexpr bool B_MIRROR = false; static constexpr bool SPLITK = false;
    __device__ __forceinline__ int total() const { return nM * nN + extra; }
    __device__ __forceinline__ long unit(int ui, int c, int G) const {
        if (t_g == 0) return (long)ui * G + c;
        const int tot = nM * nN + extra, full = tot / G;
        if (ui < full) return (long)ui * G + c;
        const int cc = c - t_c0; if (cc < 0 || cc >= t_g) return tot;
        return (long)full * G + (long)(ui - full) * t_g + cc;
    }
    __device__ __forceinline__ void decode(int L, Unit& u) const {
        const int nr = nM * nN;
        if (L < nr) tile_order(L, nM, nN, u.pm, u.pn);
        else { const int e = L - nr; u.pm = nM + e / 10; const int q = e % 10; u.pn = q < 2 ? 4 + q : 8 + q; }
        u.pa = A + (size_t)u.pm * aS; u.pb = B + (size_t)u.pn * bS; u.oo = 0; u.hb = (long)(bS >> 1);
    }
};
struct SchedUp {
    const char* A; const char* B; int nM, nN; size_t aS, bS;
    static __device__ __forceinline__ int a_row(int R) { return 126 * (R >> 6) + (R & 63); }
    static constexpr int A_HROWS = 64; static constexpr bool B_MIRROR = false; static constexpr bool SPLITK = false;
    __device__ __forceinline__ int total() const { return nM * nN; }
    __device__ __forceinline__ long unit(int ui, int c, int G) const { return (long)ui * G + c; }
    __device__ __forceinline__ void decode(int L, Unit& u) const { tile_order(L, nM, nN, u.pm, u.pn); u.pa = A + (size_t)u.pm * aS; u.pb = B + (size_t)u.pn * bS; u.oo = 0; u.hb = (long)(bS >> 1); }
};
struct SchedJob {
    const char* A; const char* B; int nZ2, nM, nN, nTot; long hbB;
    size_t az1, az2, am, bz1, bz2, bn;
    long oz1, oz2, om, on;
    static __device__ __forceinline__ int a_row(int R) { return R; }
    static constexpr int A_HROWS = 128; static constexpr bool B_MIRROR = false; static constexpr bool SPLITK = false;
    __device__ __forceinline__ int total() const { return nTot; }
    __device__ __forceinline__ long unit(int ui, int c, int G) const { return (long)ui * G + c; }
    __device__ __forceinline__ void decode(int L, Unit& u) const {
        const int per = nM * nN, z = L / per, rem = L - z * per, z1 = z / nZ2, z2 = z - z1 * nZ2;
        tile_order(rem, nM, nN, u.pm, u.pn);
        u.pa = A + (size_t)z1 * az1 + (size_t)z2 * az2 + (size_t)u.pm * am; u.pb = B + (size_t)z1 * bz1 + (size_t)z2 * bz2 + (size_t)u.pn * bn;
        u.oo = (long)z1 * oz1 + (long)z2 * oz2 + (long)u.pm * om + (long)u.pn * on; u.hb = hbB;
    }
};

struct SchedSplit {
    const char* A; const char* B; size_t aS, bS; int pairs, nctx;
    static __device__ __forceinline__ int a_row(int R) { return R; }
    static constexpr int A_HROWS = 128; static constexpr bool B_MIRROR = false; static constexpr bool SPLITK = true;
    __device__ __forceinline__ int total() const { return 1024 + nctx; }
    __device__ __forceinline__ long unit(int ui, int c, int G) const { return (long)ui * G + c; }
    __device__ __forceinline__ void decode(int L, Unit& u) const {
        if (L < 1024) { tile_order(L, 64, 16, u.pm, u.pn); u.pa = A + (size_t)u.pm * aS; u.pb = B + (size_t)u.pn * bS; u.nt = 2 * pairs; u.oo = 0; }
        else { const int e = L - 1024, tile = e >> 3, p = e & 7; u.pm = 64 + (tile >> 4); u.pn = tile & 15;
            const int q = pairs >> 3, r = pairs & 7;
            const int start = p * q + (p < r ? p : r), len = q + (p < r ? 1 : 0);
            u.pa = A + (size_t)u.pm * aS + (size_t)start * 256; u.pb = B + (size_t)u.pn * bS + (size_t)start * 256; u.nt = 2 * len; u.oo = 1 + p; }
        u.hb = (long)(bS >> 1);
    }
};
struct SchedV {
    const char* A; const char* B; int nM;
    static __device__ __forceinline__ int a_row(int R) { return R; }
    static constexpr int A_HROWS = 128; static constexpr bool B_MIRROR = false; static constexpr bool SPLITK = false;
    __device__ __forceinline__ int total() const { return nM * 43; }
    __device__ __forceinline__ long unit(int ui, int c, int G) const { return (long)ui * G + c; }
    __device__ __forceinline__ void decode(int L, Unit& u) const { tile_order(L, nM, 43, u.pm, u.pn);
        u.pa = A + (size_t)u.pm * 256 * DM * 2; u.pb = B + (size_t)(u.pn * 512 + 128) * DM * 2; u.hb = (long)256 * DM * 2; u.oo = 0; }
};
constexpr int ZK = 8320;
struct SchedS1 {
    const char* A; const char* Ub;
    static __device__ __forceinline__ int a_row(int R) { return R; }
    static constexpr int A_HROWS = 128; static constexpr bool B_MIRROR = true; static constexpr bool SPLITK = false;
    __device__ __forceinline__ int total() const { return 8 * 64; }
    __device__ __forceinline__ long unit(int ui, int c, int G) const { return (long)ui * G + c; }
    __device__ __forceinline__ void decode(int L, Unit& u) const {
        const int z = L >> 6, r = L & 63, part = r >> 5, tile = r & 31, n0 = tile * 128, b = z >> 2, g = z & 3;
        u.pm = part; u.pn = tile;
        u.pa = A + (size_t)part * 256 * 256 * 2;
        u.pb = Ub + ((size_t)(b * SEQ + n0) * ACTW + g * 256) * 2;
        u.hb = (long)(SEQ - 2 * n0) * ACTW * 2;
        u.oo = (long)z * 256 * ZK + (part ? 4096 : 0) + n0 / 2;
    }
};
struct SchedDft {
    const char* A; const char* B;
    static __device__ __forceinline__ int a_row(int R) { return R; }
    static constexpr int A_HROWS = 128; static constexpr bool B_MIRROR = false; static constexpr bool SPLITK = true;
    __device__ __forceinline__ int total() const { return 256; }
    __device__ __forceinline__ long unit(int ui, int c, int G) const { return (long)ui * G + c; }
    __device__ __forceinline__ void decode(int L, Unit& u) const {
        const int xcd = L & 7, i = L >> 3, part = xcd >> 1, z = (xcd & 1) * 4 + (i >> 3), tile = i & 7;
        u.pm = tile; u.pn = part;
        u.pa = A + ((size_t)(1 + 256 * tile) * ZK + part * 2048) * 2;
        u.pb = B + ((size_t)z * 256 * ZK + part * 2048) * 2;
        u.hb = 128L * ZK * 2; u.nt = 32; u.oo = ((long)(part * 8 + z) * 2048 + 256 * tile) * 256;
    }
};
struct EpiF32 {
    static constexpr bool PERM = true; static constexpr int HOOK_TILES = 0; static constexpr bool I8 = false;
    float* O;
    __device__ __forceinline__ void hook(f32x4 (&)[2][2][4][2], const Unit&, int, int, int, int, int) const {}
    __device__ __forceinline__ void operator()(const f32x4 (&acc)[2][2][4][2], const Unit& u, int wr, int wc, int fr, int fq) const {
        float* base = O + u.oo + wc * 32 + 8 * fq;
#pragma unroll
        for (int ai = 0; ai < 2; ++ai)
#pragma unroll
            for (int m = 0; m < 4; ++m) { float* rowp = base + (size_t)(ai * HALF + wr * 64 + m * 16 + fr) * 256;
#pragma unroll
                for (int bj = 0; bj < 2; ++bj) { *(f32x4*)(rowp + bj * HALF) = acc[ai][bj][m][0]; *(f32x4*)(rowp + bj * HALF + 4) = acc[ai][bj][m][1]; } }
    }
};
struct EpiStore {
    static constexpr bool PERM = true; static constexpr int HOOK_TILES = 0; static constexpr bool I8 = false;
    bf16* O; int ldc;
    __device__ __forceinline__ void hook(f32x4 (&)[2][2][4][2], const Unit&, int, int, int, int, int) const {}
    __device__ __forceinline__ void operator()(const f32x4 (&acc)[2][2][4][2], const Unit& u, int wr, int wc, int fr, int fq) const {
        bf16* base = O + u.oo + wc * 32 + 8 * fq;
#pragma unroll
        for (int ai = 0; ai < 2; ++ai)
#pragma unroll
            for (int m = 0; m < 4; ++m) { bf16* rowp = base + (size_t)(ai * HALF + wr * 64 + m * 16 + fr) * ldc;
#pragma unroll
                for (int bj = 0; bj < 2; ++bj) { const f32x4 v0 = acc[ai][bj][m][0], v1 = acc[ai][bj][m][1];
                    u32x4 w; w.x = cvt_pk_bf16(v0[0], v0[1]); w.y = cvt_pk_bf16(v0[2], v0[3]); w.z = cvt_pk_bf16(v1[0], v1[1]); w.w = cvt_pk_bf16(v1[2], v1[3]);
                    *(u32x4*)(rowp + bj * HALF) = w; } }
    }
};

struct EpiS1 {
    static constexpr bool PERM = true; static constexpr int HOOK_TILES = 0; static constexpr bool I8 = false;
    bf16* O;
    __device__ __forceinline__ void hook(f32x4 (&)[2][2][4][2], const Unit&, int, int, int, int, int) const {}
    __device__ __forceinline__ void operator()(const f32x4 (&acc)[2][2][4][2], const Unit& u, int wr, int wc, int fr, int fq) const {
        const float sg = u.pm ? -1.0f : 1.0f;
        const bool self0 = (u.pm == 0) && (wc == 0) && (fq == 0) && (u.pn == 0);
        bf16* base = O + u.oo + wc * 16 + 8 * (fq & 1) + ((fq >> 1) ? 2048 : 0);
#pragma unroll
        for (int ai = 0; ai < 2; ++ai)
#pragma unroll
            for (int m = 0; m < 4; ++m) { f32x4 v0 = acc[ai][0][m][0] + sg * acc[ai][1][m][0]; const f32x4 v1 = acc[ai][0][m][1] + sg * acc[ai][1][m][1];
                if (self0) v0[0] = acc[ai][0][m][0][0];
                u32x4 w; w.x = cvt_pk_bf16(v0[0], v0[1]); w.y = cvt_pk_bf16(v0[2], v0[3]); w.z = cvt_pk_bf16(v1[0], v1[1]); w.w = cvt_pk_bf16(v1[2], v1[3]);
                *(u32x4*)(base + (size_t)(ai * HALF + wr * 64 + m * 16 + fr) * ZK) = w; }
    }
};

struct EpiIn {
    static constexpr bool PERM = true; static constexpr int HOOK_TILES = 0; static constexpr bool I8 = false;
    bf16* ACT; bf16* Gt; const float* rope;
    __device__ __forceinline__ void hook(f32x4 (&)[2][2][4][2], const Unit&, int, int, int, int, int) const {}
    __device__ __forceinline__ void operator()(const f32x4 (&acc)[2][2][4][2], const Unit& u, int wr, int wc, int fr, int fq) const {
        const int pn = u.pn;
        const int colw = wc * 32 + 8 * fq;
        if (pn >= 26) {
            const int gi = (pn - 26) >> 4, gpn = (pn - 26) & 15;
            bf16* base = Gt + ((size_t)((gi * 66 + u.pm) * 16 + gpn) * 16 * 8 + (wr * 4 + wc)) * 512 + (size_t)(fq * 16 + fr) * 8;
#pragma unroll
            for (int ai = 0; ai < 2; ++ai)
#pragma unroll
                for (int m = 0; m < 4; ++m)
#pragma unroll
                    for (int bj = 0; bj < 2; ++bj) { const f32x4 v0 = acc[ai][bj][m][0], v1 = acc[ai][bj][m][1];
                        u32x4 w; w.x = cvt_pk_bf16(sigmoidf_(v0[0]), sigmoidf_(v0[1])); w.y = cvt_pk_bf16(sigmoidf_(v0[2]), sigmoidf_(v0[3]));
                        w.z = cvt_pk_bf16(sigmoidf_(v1[0]), sigmoidf_(v1[1])); w.w = cvt_pk_bf16(sigmoidf_(v1[2]), sigmoidf_(v1[3]));
                        *(u32x4*)(base + (size_t)((ai * 4 + m) * 2 + bj) * 4096) = w; }
            return;
        }
        const bool do_rope = pn <= 4;
        const float qs = (pn < 4 || (pn >= 6 && pn < 10)) ? QSCALE : 1.0f;
        bf16* base = ACT + (size_t)pn * 256 + colw;
        const int hf = wc >> 1, i0 = 16 * (wc & 1) + 4 * fq;
        f32x4 csa[8], csb[8];
#pragma unroll
        for (int k = 0; k < 8; ++k) { csa[k] = (f32x4){1.f, 0.f, 1.f, 0.f}; csb[k] = csa[k]; const int row = u.pm * BM + (k >> 2) * HALF + wr * 64 + (k & 3) * 16 + fr;
            if (do_rope && row < TL) { const int t = row & (SEQ - 1), pos = hf ? (t & 63) : (t >> 6); const f32x4* rp = (const f32x4*)(rope + (size_t)(pos * 32 + i0) * 2); csa[k] = rp[0]; csb[k] = rp[1]; } }
#pragma unroll
        for (int ai = 0; ai < 2; ++ai)
#pragma unroll
            for (int m = 0; m < 4; ++m) { const int row = u.pm * BM + ai * HALF + wr * 64 + m * 16 + fr; bf16* rowp = base + (size_t)row * ACTW;
                const f32x4 cs0 = csa[ai * 4 + m], cs1 = csb[ai * 4 + m];
#pragma unroll
                for (int bj = 0; bj < 2; ++bj) { f32x4 v0 = acc[ai][bj][m][0] * qs, v1 = acc[ai][bj][m][1] * qs;
                    if (do_rope) { f32x4 y0, y1;
                        y0[0] = v0[0] * cs0[0] - v0[1] * cs0[1]; y0[1] = v0[0] * cs0[1] + v0[1] * cs0[0]; y0[2] = v0[2] * cs0[2] - v0[3] * cs0[3]; y0[3] = v0[2] * cs0[3] + v0[3] * cs0[2];
                        y1[0] = v1[0] * cs1[0] - v1[1] * cs1[1]; y1[1] = v1[0] * cs1[1] + v1[1] * cs1[0]; y1[2] = v1[2] * cs1[2] - v1[3] * cs1[3]; y1[3] = v1[2] * cs1[3] + v1[3] * cs1[2];
                        v0 = y0; v1 = y1; }
                    u32x4 w; w.x = cvt_pk_bf16(v0[0], v0[1]); w.y = cvt_pk_bf16(v0[2], v0[3]); w.z = cvt_pk_bf16(v1[0], v1[1]); w.w = cvt_pk_bf16(v1[2], v1[3]);
                    *(u32x4*)(rowp + bj * HALF) = w; } }
    }
};

struct EpiGate {
    static constexpr bool PERM = true; static constexpr int HOOK_TILES = 0; static constexpr bool I8 = true;
    bf16* Gt; const float* SH; const float* SW;
    __device__ __forceinline__ void hook(f32x4 (&)[2][2][4][2], const Unit&, int, int, int, int, int) const {}
    __device__ __forceinline__ void operator()(const f32x4 (&acc)[2][2][4][2], const Unit& u, int wr, int wc, int fr, int fq) const {
        const int gi = u.pn >> 4, gpn = u.pn & 15;
        float shr[8]; f32x4 swc[2][2];
#pragma unroll
        for (int k = 0; k < 8; ++k) shr[k] = SH[u.pm * BM + (k >> 2) * HALF + wr * 64 + (k & 3) * 16 + fr];
#pragma unroll
        for (int bj = 0; bj < 2; ++bj)
#pragma unroll
            for (int n = 0; n < 2; ++n) swc[bj][n] = *(const f32x4*)(SW + u.pn * BM + bj * HALF + wc * 32 + 8 * fq + 4 * n) * (-LOG2E);
        bf16* base = Gt + ((size_t)((gi * 66 + u.pm) * 16 + gpn) * 16 * 8 + (wr * 4 + wc)) * 512 + (size_t)(fq * 16 + fr) * 8;
#pragma unroll
        for (int ai = 0; ai < 2; ++ai)
#pragma unroll
            for (int m = 0; m < 4; ++m)
#pragma unroll
                for (int bj = 0; bj < 2; ++bj) { const i32x4 a0 = __builtin_bit_cast(i32x4, acc[ai][bj][m][0]), a1 = __builtin_bit_cast(i32x4, acc[ai][bj][m][1]); const float rs = shr[ai * 4 + m];
                    f32x4 v0, v1;
#pragma unroll
                    for (int j = 0; j < 4; ++j) { v0[j] = (float)a0[j] * rs * swc[bj][0][j]; v1[j] = (float)a1[j] * rs * swc[bj][1][j]; }
#define SG2(x) fast_rcp(1.0f + fast_exp2(x))
                    u32x4 w; w.x = cvt_pk_bf16(SG2(v0[0]), SG2(v0[1])); w.y = cvt_pk_bf16(SG2(v0[2]), SG2(v0[3]));
                    w.z = cvt_pk_bf16(SG2(v1[0]), SG2(v1[1])); w.w = cvt_pk_bf16(SG2(v1[2]), SG2(v1[3]));
#undef SG2
                    *(u32x4*)(base + (size_t)((ai * 4 + m) * 2 + bj) * 4096) = w; }
    }
};

struct EpiMerge {
    static constexpr bool PERM = true; static constexpr int HOOK_TILES = 16; static constexpr bool I8 = false;
    const bf16* Gt; bf16* MG; float* slab;
    static __device__ __forceinline__ float clampg(float s) { return fmaxf(s, 1e-9f); }
    __device__ __forceinline__ void hook(f32x4 (&acc)[2][2][4][2], const Unit& u, int j1, int wr, int wc, int fr, int fq) const {
        asm volatile("" : "+v"(fr), "+v"(fq));
        const bf16* g0 = Gt + ((size_t)(((j1 - 1) * 66 + u.pm) * 16 + u.pn) * 16 * 8 + (wr * 4 + wc)) * 512 + (size_t)(fq * 16 + fr) * 8;
        const bf16* g1 = g0 + (size_t)66 * 16 * 16 * 8 * 512;
#pragma unroll
        for (int ai = 0; ai < 2; ++ai) {
            u32x4 ga[4][2], gb[4][2];
#pragma unroll
            for (int m = 0; m < 4; ++m)
#pragma unroll
                for (int bj = 0; bj < 2; ++bj) { const size_t go = (size_t)((ai * 4 + m) * 2 + bj) * 4096; ga[m][bj] = *(const u32x4*)(g0 + go); gb[m][bj] = *(const u32x4*)(g1 + go); }
            asm volatile("s_waitcnt vmcnt(0)" ::: "memory");
#pragma unroll
            for (int m = 0; m < 4; ++m)
#pragma unroll
                for (int bj = 0; bj < 2; ++bj) { const u32x4 a = ga[m][bj], b = gb[m][bj];
                    f32x4 r0, r1;
                    r0[0] = clampg(bflo(a.x)) * fast_rcp(clampg(bflo(b.x))); r0[1] = clampg(bfhi(a.x)) * fast_rcp(clampg(bfhi(b.x)));
                    r0[2] = clampg(bflo(a.y)) * fast_rcp(clampg(bflo(b.y))); r0[3] = clampg(bfhi(a.y)) * fast_rcp(clampg(bfhi(b.y)));
                    r1[0] = clampg(bflo(a.z)) * fast_rcp(clampg(bflo(b.z))); r1[1] = clampg(bfhi(a.z)) * fast_rcp(clampg(bfhi(b.z)));
                    r1[2] = clampg(bflo(a.w)) * fast_rcp(clampg(bflo(b.w))); r1[3] = clampg(bfhi(a.w)) * fast_rcp(clampg(bfhi(b.w)));
                    acc[ai][bj][m][0] *= r0; acc[ai][bj][m][1] *= r1; }
            asm volatile("" ::: "memory");
        }
    }
    __device__ __forceinline__ void operator()(const f32x4 (&acc)[2][2][4][2], const Unit& u, int wr, int wc, int fr, int fq) const {
        const size_t cofs = (size_t)u.pn * 256 + wc * 32 + 8 * fq;
        if (u.oo >= 1) {
            const int p = (int)u.oo - 1;
            const bf16* gi = Gt + ((size_t)(((p >> 1) * 66 + u.pm) * 16 + u.pn) * 16 * 8 + (wr * 4 + wc)) * 512 + (size_t)(fq * 16 + fr) * 8;
            float* sl = slab + (size_t)p * TC * DM + cofs;
#pragma unroll
            for (int ai = 0; ai < 2; ++ai) {
                u32x4 ga[4][2];
#pragma unroll
                for (int m = 0; m < 4; ++m)
#pragma unroll
                    for (int bj = 0; bj < 2; ++bj) ga[m][bj] = *(const u32x4*)(gi + (size_t)((ai * 4 + m) * 2 + bj) * 4096);
#pragma unroll
                for (int m = 0; m < 4; ++m) { const size_t row = (size_t)(u.pm * BM + ai * HALF + wr * 64 + m * 16 + fr - TL);
#pragma unroll
                    for (int bj = 0; bj < 2; ++bj) { const u32x4 a = ga[m][bj]; const f32x4 v0 = acc[ai][bj][m][0], v1 = acc[ai][bj][m][1];
                        const f32x4 o0 = {v0[0] * clampg(bflo(a.x)), v0[1] * clampg(bfhi(a.x)), v0[2] * clampg(bflo(a.y)), v0[3] * clampg(bfhi(a.y))};
                        const f32x4 o1 = {v1[0] * clampg(bflo(a.z)), v1[1] * clampg(bfhi(a.z)), v1[2] * clampg(bflo(a.w)), v1[3] * clampg(bfhi(a.w))};
                        *(f32x4*)(sl + row * DM + bj * HALF) = o0; *(f32x4*)(sl + row * DM + bj * HALF + 4) = o1; } } }
            return;
        }
        const bf16* g3 = Gt + ((size_t)((3 * 66 + u.pm) * 16 + u.pn) * 16 * 8 + (wr * 4 + wc)) * 512 + (size_t)(fq * 16 + fr) * 8;
#pragma unroll
        for (int ai = 0; ai < 2; ++ai) {
            u32x4 ga[4][2];
#pragma unroll
            for (int m = 0; m < 4; ++m)
#pragma unroll
                for (int bj = 0; bj < 2; ++bj) ga[m][bj] = *(const u32x4*)(g3 + (size_t)((ai * 4 + m) * 2 + bj) * 4096);
#pragma unroll
            for (int m = 0; m < 4; ++m) { const size_t row = (size_t)(u.pm * BM + ai * HALF + wr * 64 + m * 16 + fr);
#pragma unroll
                for (int bj = 0; bj < 2; ++bj) { const u32x4 a = ga[m][bj]; const f32x4 v0 = acc[ai][bj][m][0], v1 = acc[ai][bj][m][1];
                    u32x4 w; w.x = cvt_pk_bf16(v0[0] * clampg(bflo(a.x)), v0[1] * clampg(bfhi(a.x))); w.y = cvt_pk_bf16(v0[2] * clampg(bflo(a.y)), v0[3] * clampg(bfhi(a.y)));
                    w.z = cvt_pk_bf16(v1[0] * clampg(bflo(a.z)), v1[1] * clampg(bfhi(a.z))); w.w = cvt_pk_bf16(v1[2] * clampg(bflo(a.w)), v1[3] * clampg(bfhi(a.w)));
                    *(u32x4*)(MG + row * DM + cofs + bj * HALF) = w; } }
            asm volatile("" ::: "memory");
        }
    }
};

struct EpiResid {
    static constexpr bool PERM = false; static constexpr int HOOK_TILES = 0; static constexpr bool I8 = false;
    const float* r_lat; const float* r_ctx; float* X; const float* gt; float* slab;
    __device__ __forceinline__ void hook(f32x4 (&)[2][2][4][2], const Unit&, int, int, int, int, int) const {}
    __device__ __forceinline__ void operator()(const f32x4 (&acc)[2][2][4][2], const Unit& u, int wr, int wc, int fr, int fq) const {
        const int var = u.pm < 32 ? 0 : (u.pm < 64 ? 1 : 2);
        const int col0 = u.pn * BM + wc * 32 + 4 * fq;
        const float* gv = gt + (size_t)var * MODW + col0;
        f32x4 gg[2][2];
#pragma unroll
        for (int bj = 0; bj < 2; ++bj)
#pragma unroll
            for (int n = 0; n < 2; ++n) gg[bj][n] = *(const f32x4*)(gv + bj * HALF + n * 16);
        if (u.oo >= 1) {
            float* sl = slab + (size_t)(u.oo - 1) * TC * DM;
#pragma unroll
            for (int ai = 0; ai < 2; ++ai)
#pragma unroll
                for (int m = 0; m < 4; ++m) { const int row = u.pm * BM + ai * HALF + wr * 64 + m * 16 + fr - TL; float* xp = sl + (size_t)row * DM + col0;
#pragma unroll
                    for (int bj = 0; bj < 2; ++bj)
#pragma unroll
                        for (int n = 0; n < 2; ++n) *(f32x4*)(xp + bj * HALF + n * 16) = gg[bj][n] * acc[ai][bj][m][n]; }
            return;
        }
#pragma unroll
        for (int ai = 0; ai < 2; ++ai) {
            f32x4 rr[4][2][2];
#pragma unroll
            for (int m = 0; m < 4; ++m) { const int row = u.pm * BM + ai * HALF + wr * 64 + m * 16 + fr;
                const float* rp = (row < TL ? r_lat + (size_t)row * DM : r_ctx + (size_t)(row - TL) * DM) + col0;
#pragma unroll
                for (int bj = 0; bj < 2; ++bj)
#pragma unroll
                    for (int n = 0; n < 2; ++n) rr[m][bj][n] = *(const f32x4*)(rp + bj * HALF + n * 16); }
#pragma unroll
            for (int m = 0; m < 4; ++m) { const int row = u.pm * BM + ai * HALF + wr * 64 + m * 16 + fr; float* xp = X + (size_t)row * DM + col0;
#pragma unroll
                for (int bj = 0; bj < 2; ++bj)
#pragma unroll
                    for (int n = 0; n < 2; ++n) *(f32x4*)(xp + bj * HALF + n * 16) = rr[m][bj][n] + gg[bj][n] * acc[ai][bj][m][n]; }
            asm volatile("" ::: "memory");
        }
    }
};

__device__ __forceinline__ float dpp_ror1(float x) { return __builtin_bit_cast(float, __builtin_amdgcn_update_dpp(0, __builtin_bit_cast(int, x), 0x121, 0xF, 0xF, false)); }
__device__ __forceinline__ float dpp_ror15(float x) { return __builtin_bit_cast(float, __builtin_amdgcn_update_dpp(0, __builtin_bit_cast(int, x), 0x12F, 0xF, 0xF, false)); }
struct EpiA8 {
    static constexpr bool PERM = true; static constexpr int HOOK_TILES = 0; static constexpr bool I8 = true;
    bf16* U; const float* cw; const float* cb; const float* SH; const float* SW;
    __device__ __forceinline__ void hook(f32x4 (&)[2][2][4][2], const Unit&, int, int, int, int, int) const {}
    __device__ __forceinline__ void operator()(const f32x4 (&acc)[2][2][4][2], const Unit& u, int wr, int wc, int fr, int fq) const {
        const int Rbase = 252 * u.pm - 1 + 126 * wr;
        float shr[8];
#pragma unroll
        for (int k = 0; k < 8; ++k) { const int R = Rbase + 16 * k + fr; shr[k] = SH[min(max(R, 0), T - 1)]; }
        int lfr = fr;
#pragma unroll
        for (int bj = 0; bj < 2; ++bj) {
            asm volatile("" : "+v"(lfr));
            const int ch0 = u.pn * 256 + bj * 128 + wc * 32 + 8 * fq;
            float w0[8], w1[8], w2[8], bb[8], sw[8];
            { const f32x4 a0 = *(const f32x4*)(cw + ch0), a1 = *(const f32x4*)(cw + ch0 + 4), b0 = *(const f32x4*)(cw + DFF + ch0), b1 = *(const f32x4*)(cw + DFF + ch0 + 4);
              const f32x4 c0 = *(const f32x4*)(cw + 2 * DFF + ch0), c1 = *(const f32x4*)(cw + 2 * DFF + ch0 + 4), d0 = *(const f32x4*)(cb + ch0), d1 = *(const f32x4*)(cb + ch0 + 4);
              const f32x4 e0 = *(const f32x4*)(SW + ch0), e1 = *(const f32x4*)(SW + ch0 + 4);
#pragma unroll
              for (int q = 0; q < 4; ++q) { w0[q] = a0[q]; w0[4 + q] = a1[q]; w1[q] = b0[q]; w1[4 + q] = b1[q]; w2[q] = c0[q]; w2[4 + q] = c1[q]; bb[q] = d0[q]; bb[4 + q] = d1[q]; sw[q] = e0[q]; sw[4 + q] = e1[q]; } }
#define A8G(k, cc) ((float)__builtin_bit_cast(i32x4, acc[(k) >> 2][bj][(k) & 3][(cc) >> 2])[(cc) & 3] * shr[k] * sw[cc])
            float spp[8], spc[8], snc[8], snn[8], gcur[8], gnx[8];
#pragma unroll
            for (int cc = 0; cc < 8; ++cc) { spp[cc] = 0.f; gcur[cc] = A8G(0, cc); spc[cc] = dpp_ror1(gcur[cc]); snc[cc] = dpp_ror15(gcur[cc]); }
#pragma unroll
            for (int k = 0; k < 8; ++k) {
                asm volatile("" : "+v"(lfr));
                if (k < 7) {
#pragma unroll
                    for (int cc = 0; cc < 8; ++cc) { gnx[cc] = A8G(k + 1, cc); snn[cc] = dpp_ror15(gnx[cc]); }
                } else {
#pragma unroll
                    for (int cc = 0; cc < 8; ++cc) { gnx[cc] = 0.f; snn[cc] = 0.f; }
                }
                const int y = 16 * k + lfr, R = Rbase + y;
                const bool fst = (R < TL) ? ((R & (SEQ - 1)) == 0) : ((R & 255) == 0), lst = (R < TL) ? ((R & (SEQ - 1)) == SEQ - 1) : ((R & 255) == 255);
                float res[8];
#pragma unroll
                for (int cc = 0; cc < 8; ++cc) {
                    float P = (lfr > 0) ? spc[cc] : spp[cc], N = (lfr < 15) ? snc[cc] : snn[cc];
                    P = fst ? 0.f : P; N = lst ? 0.f : N;
                    const float a = w0[cc] * P + w1[cc] * gcur[cc] + w2[cc] * N + bb[cc];
                    res[cc] = a * sigmoidf_(a);
                }
                if (y >= 1 && y <= 126 && R < T) { u32x4 w; w.x = cvt_pk_bf16(res[0], res[1]); w.y = cvt_pk_bf16(res[2], res[3]); w.z = cvt_pk_bf16(res[4], res[5]); w.w = cvt_pk_bf16(res[6], res[7]);
                    *(u32x4*)(U + (size_t)R * DFF + ch0) = w; }
                if (k < 7) {
#pragma unroll
                    for (int cc = 0; cc < 8; ++cc) { spp[cc] = spc[cc]; gcur[cc] = gnx[cc]; spc[cc] = dpp_ror1(gnx[cc]); snc[cc] = snn[cc]; }
                }
            }
#undef A8G
        }
    }
};
struct EpiUp8 {
    static constexpr bool PERM = true; static constexpr int HOOK_TILES = 0; static constexpr bool I8 = true;
    bf16* U; const float* cw; const float* cb; const float* SH; const float* SW;
    __device__ __forceinline__ void hook(f32x4 (&)[2][2][4][2], const Unit&, int, int, int, int, int) const {}
    __device__ __forceinline__ void operator()(const f32x4 (&acc)[2][2][4][2], const Unit& u, int wr, int wc, int fr, int fq) const {
        const int Rbase = 252 * u.pm - 1 + 126 * wr;
        const int ch0 = u.pn * 128 + wc * 32 + 8 * fq;
        float shr[8];
#pragma unroll
        for (int k = 0; k < 8; ++k) { const int R = Rbase + 16 * k + fr; shr[k] = SH[min(max(R, 0), T - 1)]; }
        float w0[8], w1[8], w2[8], bb[8], swg[8], swv[8];
        { const f32x4 a0 = *(const f32x4*)(cw + ch0), a1 = *(const f32x4*)(cw + ch0 + 4), b0 = *(const f32x4*)(cw + DFF + ch0), b1 = *(const f32x4*)(cw + DFF + ch0 + 4);
          const f32x4 c0 = *(const f32x4*)(cw + 2 * DFF + ch0), c1 = *(const f32x4*)(cw + 2 * DFF + ch0 + 4), d0 = *(const f32x4*)(cb + ch0), d1 = *(const f32x4*)(cb + ch0 + 4);
          const float* sp = SW + u.pn * 256 + wc * 32 + 8 * fq;
          const f32x4 e0 = *(const f32x4*)sp, e1 = *(const f32x4*)(sp + 4), f0 = *(const f32x4*)(sp + 128), f1 = *(const f32x4*)(sp + 132);
#pragma unroll
          for (int q = 0; q < 4; ++q) { w0[q] = a0[q]; w0[4 + q] = a1[q]; w1[q] = b0[q]; w1[4 + q] = b1[q]; w2[q] = c0[q]; w2[4 + q] = c1[q]; bb[q] = d0[q]; bb[4 + q] = d1[q];
              swg[q] = e0[q]; swg[4 + q] = e1[q]; swv[q] = f0[q]; swv[4 + q] = f1[q]; } }
#define U8G(k, cc) ((float)__builtin_bit_cast(i32x4, acc[(k) >> 2][0][(k) & 3][(cc) >> 2])[(cc) & 3] * shr[k])
#define U8V(k, cc) ((float)__builtin_bit_cast(i32x4, acc[(k) >> 2][1][(k) & 3][(cc) >> 2])[(cc) & 3] * shr[k] * swv[cc])
#pragma unroll
        for (int cc = 0; cc < 8; ++cc) { w0[cc] *= swg[cc]; w1[cc] *= swg[cc]; w2[cc] *= swg[cc]; }
        int lfr = fr;
        float spp[8], spc[8], snc[8], snn[8], gcur[8], gnx[8];
#pragma unroll
        for (int cc = 0; cc < 8; ++cc) { spp[cc] = 0.f; gcur[cc] = U8G(0, cc); spc[cc] = dpp_ror1(gcur[cc]); snc[cc] = dpp_ror15(gcur[cc]); }
#pragma unroll
        for (int k = 0; k < 8; ++k) {
            asm volatile("" : "+v"(lfr));
            if (k < 7) {
#pragma unroll
                for (int cc = 0; cc < 8; ++cc) { gnx[cc] = U8G(k + 1, cc); snn[cc] = dpp_ror15(gnx[cc]); }
            } else {
#pragma unroll
                for (int cc = 0; cc < 8; ++cc) { gnx[cc] = 0.f; snn[cc] = 0.f; }
            }
            const int y = 16 * k + lfr, R = Rbase + y;
            const bool fst = (R < TL) ? ((R & (SEQ - 1)) == 0) : ((R & 255) == 0), lst = (R < TL) ? ((R & (SEQ - 1)) == SEQ - 1) : ((R & 255) == 255);
            float res[8];
#pragma unroll
            for (int cc = 0; cc < 8; ++cc) {
                float P = (lfr > 0) ? spc[cc] : spp[cc], N = (lfr < 15) ? snc[cc] : snn[cc];
                P = fst ? 0.f : P; N = lst ? 0.f : N;
                const float a = w0[cc] * P + w1[cc] * gcur[cc] + w2[cc] * N + bb[cc];
                res[cc] = a * sigmoidf_(a) * U8V(k, cc);
            }
            if (y >= 1 && y <= 126 && R < T) { u32x4 w; w.x = cvt_pk_bf16(res[0], res[1]); w.y = cvt_pk_bf16(res[2], res[3]); w.z = cvt_pk_bf16(res[4], res[5]); w.w = cvt_pk_bf16(res[6], res[7]);
                *(u32x4*)(U + (size_t)R * DFF + ch0) = w; }
            if (k < 7) {
#pragma unroll
                for (int cc = 0; cc < 8; ++cc) { spp[cc] = spc[cc]; gcur[cc] = gnx[cc]; spc[cc] = dpp_ror1(gnx[cc]); snc[cc] = snn[cc]; }
            }
        }
#undef U8G
#undef U8V
    }
};
struct EpiV8 {
    static constexpr bool PERM = true; static constexpr int HOOK_TILES = 0; static constexpr bool I8 = true;
    bf16* U; const float* SH; const float* SW;
    __device__ __forceinline__ void hook(f32x4 (&)[2][2][4][2], const Unit&, int, int, int, int, int) const {}
    __device__ __forceinline__ void operator()(const f32x4 (&acc)[2][2][4][2], const Unit& u, int wr, int wc, int fr, int fq) const {
        bf16* base = U + (size_t)u.pn * 256 + wc * 32 + 8 * fq;
        float shr[8]; f32x4 swc[2][2];
#pragma unroll
        for (int k = 0; k < 8; ++k) shr[k] = SH[u.pm * BM + (k >> 2) * HALF + wr * 64 + (k & 3) * 16 + fr];
#pragma unroll
        for (int bj = 0; bj < 2; ++bj)
#pragma unroll
            for (int n = 0; n < 2; ++n) swc[bj][n] = *(const f32x4*)(SW + u.pn * BM + bj * HALF + wc * 32 + 8 * fq + 4 * n);
#pragma unroll
        for (int ai = 0; ai < 2; ++ai) {
            u32x4 gg[4][2];
#pragma unroll
            for (int m = 0; m < 4; ++m)
#pragma unroll
                for (int bj = 0; bj < 2; ++bj) gg[m][bj] = *(const u32x4*)(base + (size_t)(u.pm * BM + ai * HALF + wr * 64 + m * 16 + fr) * DFF + bj * HALF);
#pragma unroll
            for (int m = 0; m < 4; ++m)
#pragma unroll
                for (int bj = 0; bj < 2; ++bj) { const u32x4 a = gg[m][bj]; const i32x4 a0 = __builtin_bit_cast(i32x4, acc[ai][bj][m][0]), a1 = __builtin_bit_cast(i32x4, acc[ai][bj][m][1]); const float rs = shr[ai * 4 + m];
                    f32x4 v0, v1;
#pragma unroll
                    for (int j = 0; j < 4; ++j) { v0[j] = (float)a0[j] * rs * swc[bj][0][j]; v1[j] = (float)a1[j] * rs * swc[bj][1][j]; }
                    u32x4 w; w.x = cvt_pk_bf16(v0[0] * bflo(a.x), v0[1] * bfhi(a.x)); w.y = cvt_pk_bf16(v0[2] * bflo(a.y), v0[3] * bfhi(a.y));
                    w.z = cvt_pk_bf16(v1[0] * bflo(a.z), v1[1] * bfhi(a.z)); w.w = cvt_pk_bf16(v1[2] * bflo(a.w), v1[3] * bfhi(a.w));
                    *(u32x4*)(base + (size_t)(u.pm * BM + ai * HALF + wr * 64 + m * 16 + fr) * DFF + bj * HALF) = w; }
            asm volatile("" ::: "memory");
        }
    }
};
struct EpiV {
    static constexpr bool PERM = true; static constexpr int HOOK_TILES = 0; static constexpr bool I8 = false;
    bf16* U;
    __device__ __forceinline__ void hook(f32x4 (&)[2][2][4][2], const Unit&, int, int, int, int, int) const {}
    __device__ __forceinline__ void operator()(const f32x4 (&acc)[2][2][4][2], const Unit& u, int wr, int wc, int fr, int fq) const {
        bf16* base = U + (size_t)u.pn * 256 + wc * 32 + 8 * fq;
#pragma unroll
        for (int ai = 0; ai < 2; ++ai) {
            u32x4 gg[4][2];
#pragma unroll
            for (int m = 0; m < 4; ++m)
#pragma unroll
                for (int bj = 0; bj < 2; ++bj) gg[m][bj] = *(const u32x4*)(base + (size_t)(u.pm * BM + ai * HALF + wr * 64 + m * 16 + fr) * DFF + bj * HALF);
#pragma unroll
            for (int m = 0; m < 4; ++m)
#pragma unroll
                for (int bj = 0; bj < 2; ++bj) { const u32x4 a = gg[m][bj]; const f32x4 v0 = acc[ai][bj][m][0], v1 = acc[ai][bj][m][1];
                    u32x4 w; w.x = cvt_pk_bf16(v0[0] * bflo(a.x), v0[1] * bfhi(a.x)); w.y = cvt_pk_bf16(v0[2] * bflo(a.y), v0[3] * bfhi(a.y));
                    w.z = cvt_pk_bf16(v1[0] * bflo(a.z), v1[1] * bfhi(a.z)); w.w = cvt_pk_bf16(v1[2] * bflo(a.w), v1[3] * bfhi(a.w));
                    *(u32x4*)(base + (size_t)(u.pm * BM + ai * HALF + wr * 64 + m * 16 + fr) * DFF + bj * HALF) = w; }
            asm volatile("" ::: "memory");
        }
    }
};
}

namespace att {
constexpr int SHM_V = 16384, SHM_K = 16384;
constexpr int OFF_V = 0, OFF_K = 2 * SHM_V, OFF_WS = 2 * SHM_V + 2 * SHM_K, OFF_TAB = OFF_WS + NWAVES * 256;
constexpr float THR = 11.5f;
#define KSWZ(row, colB) ((row) * 256 + ((colB) ^ (((row) & 7) << 4)))
#define SBAR() __builtin_amdgcn_sched_barrier(0)
__device__ __forceinline__ int crow(int r, int hi) { return (r & 3) + 8 * (r >> 2) + 4 * hi; }
__device__ __forceinline__ int v_st(int k, int c) { const int kk = (k & ~0xC) | ((k & 4) << 1) | ((k & 8) >> 1); return ((kk >> 3) * 4 + (c >> 5)) * 512 + ((kk & 7) * 32 + (c & 31)) * 2; }
__device__ __forceinline__ int v_rd_base(int lane) { return ((lane & 3) << 3) | (((lane >> 2) & 3) << 6) | (((lane >> 4) & 1) << 5) | (((lane >> 5) & 1) << 8); }
constexpr int v_rd_off(int d0, int ks, int half) { return d0 * 512 + ks * 4096 + half * 2048; }
template <int OFF> __device__ __forceinline__ s16x4 tr_read(int vb) { s16x4 r; asm volatile("ds_read_b64_tr_b16 %0, %1 offset:%2" : "=&v"(r) : "v"(vb), "i"(OFF) : "memory"); return r; }
template <int D0> __device__ __forceinline__ void pv_one(f32x16& od, int vb, bf16x8 pa0, bf16x8 pa1, bf16x8 pa2, bf16x8 pa3) {
    const s16x4 l0 = tr_read<v_rd_off(D0, 0, 0)>(vb), h0 = tr_read<v_rd_off(D0, 0, 1)>(vb), l1 = tr_read<v_rd_off(D0, 1, 0)>(vb), h1 = tr_read<v_rd_off(D0, 1, 1)>(vb);
    const s16x4 l2 = tr_read<v_rd_off(D0, 2, 0)>(vb), h2 = tr_read<v_rd_off(D0, 2, 1)>(vb), l3 = tr_read<v_rd_off(D0, 3, 0)>(vb), h3 = tr_read<v_rd_off(D0, 3, 1)>(vb);
    asm volatile("s_waitcnt lgkmcnt(0)" ::: "memory"); SBAR();
#define PK(L, H) (bf16x8){L[0], L[1], L[2], L[3], H[0], H[1], H[2], H[3]}
    od = __builtin_amdgcn_mfma_f32_32x32x16_bf16(pa0, PK(l0, h0), od, 0, 0, 0);
    od = __builtin_amdgcn_mfma_f32_32x32x16_bf16(pa1, PK(l1, h1), od, 0, 0, 0);
    od = __builtin_amdgcn_mfma_f32_32x32x16_bf16(pa2, PK(l2, h2), od, 0, 0, 0);
    od = __builtin_amdgcn_mfma_f32_32x32x16_bf16(pa3, PK(l3, h3), od, 0, 0, 0);
#undef PK
}
__device__ __forceinline__ void qkt(f32x16& p0, f32x16& p1, const LAS char* Ks, const bf16x8 (&qr)[8], int r32, int hi) {
    p0 = f32x16{}; p1 = f32x16{};
#pragma unroll
    for (int d0 = 0; d0 < 8; ++d0) { const int cb = (d0 * 16 + hi * 8) * 2;
        const bf16x8 b0 = *(const LAS bf16x8*)(Ks + KSWZ(r32, cb));
        const bf16x8 b1 = *(const LAS bf16x8*)(Ks + KSWZ(32 + r32, cb));
        p0 = __builtin_amdgcn_mfma_f32_32x32x16_bf16(b0, qr[d0], p0, 0, 0, 0);
        p1 = __builtin_amdgcn_mfma_f32_32x32x16_bf16(b1, qr[d0], p1, 0, 0, 0); }
}

__device__ __forceinline__ void attn_unit(LAS char* lds, const bf16* __restrict__ ACT, bf16* __restrict__ YC, const float* __restrict__ sink, const float* __restrict__ rpb,
                                          int kind, int b, int hh, int blk) {
    int tid_ = threadIdx.x; asm volatile("" : "+v"(tid_));
    const int tid = tid_, wid = __builtin_amdgcn_readfirstlane(tid >> 6), lane = tid & 63, r32 = lane & 31, hi = lane >> 5;
    LAS char* V_lds = lds + OFF_V; LAS char* K_lds = lds + OFF_K;
    LAS float* wsf = (LAS float*)(lds + OFF_WS) + wid * 64; LAS float* li_l = wsf; LAS float* al_l = wsf + 32;
    LAS float* tab = (LAS float*)(lds + OFF_TAB);
    const bool isA = (kind == 0 || kind == 2);
    int head, qrow0;
    if (kind == 0)      { head = hh * 4 + (wid >> 1); qrow0 = b * SEQ + blk * 64 + (wid & 1) * 32; }
    else if (kind == 1) { head = hh;                  qrow0 = b * SEQ + blk * 256 + wid * 32; }
    else if (kind == 2) { head = hh * 4 + (wid >> 1); qrow0 = TL + b * CTXL + blk * 64 + (wid & 1) * 32; }
    else                { head = hh;                  qrow0 = TL + b * CTXL + wid * 32; }
    const int qcolofs = isA ? OFF_AQ + head * 128 : OFF_NQ + head * 128;
    const int ocol = isA ? head * 128 : 1024 + head * 128;
    const int kcol = isA ? OFF_AK + hh * 128 : OFF_NK + hh * 128, vcol = isA ? OFF_AV + hh * 128 : OFF_NV + hh * 128;
    const int NT = kind == 0 ? 9 : (kind == 1 ? 15 : 4);
    const int krow0 = kind == 1 ? min(max(blk * 4 - 4, 0), 117) : 0;
    const int kp00 = blk * 64 - 128;
    if (kind == 1) { if (tid < 465) tab[tid] = rpb[head * 465 + tid] * LOG2E; }
    bf16x8 qr[8];
    { const bf16* Qw = ACT + (size_t)(qrow0 + r32) * ACTW + qcolofs + hi * 8;
#pragma unroll
      for (int d0 = 0; d0 < 8; ++d0) qr[d0] = *(const bf16x8*)(Qw + d0 * 16); }
    float m_reg, l_reg;
    if (isA) { m_reg = sink[head] * LOG2E; l_reg = 1.f; } else { m_reg = -1e30f; l_reg = 0.f; }
    f32x16 o[4] = {};
    const int sr = tid >> 4, sc = (tid & 15) * 8, vst0 = v_st(sr, sc), vst1 = v_st(32 + sr, sc);
    const int vb0 = (int)(unsigned)(uintptr_t)V_lds + v_rd_base(lane);
    bf16x8 vs0, vs1, ks0, ks1;
#define GROW(j, r) ((j) < 4 ? (size_t)(TL + b * CTXL + (j) * 64 + (r)) : (kind == 0 ? (size_t)(b * SEQ + min(max(kp00 + ((j) - 4) * 64 + (r), 0), SEQ - 1)) : (size_t)(b * SEQ + (krow0 + (j) - 4) * 64 + (r))))
#define SLOAD(j) do { const bf16* r0p = ACT + GROW((j), sr) * ACTW + sc; const bf16* r1p = ACT + GROW((j), 32 + sr) * ACTW + sc; \
        vs0 = *(const bf16x8*)(r0p + vcol); vs1 = *(const bf16x8*)(r1p + vcol); ks0 = *(const bf16x8*)(r0p + kcol); ks1 = *(const bf16x8*)(r1p + kcol); } while (0)
#define SWRITE(bb) do { *(LAS bf16x8*)(V_lds + (bb) * SHM_V + vst0) = vs0; *(LAS bf16x8*)(V_lds + (bb) * SHM_V + vst1) = vs1; const int kc = sc * 2; \
        *(LAS bf16x8*)(K_lds + (bb) * SHM_K + KSWZ(sr, kc)) = ks0; *(LAS bf16x8*)(K_lds + (bb) * SHM_K + KSWZ(32 + sr, kc)) = ks1; } while (0)
    SLOAD(0); SWRITE(0); __syncthreads();
    const int qpos = blk * 64 + (wid & 1) * 32 + r32;
    const int qgr = blk * 4 + (wid >> 1), qgc = (wid & 1) * 32 + r32;
    const int rs = min(max(qgr - 4, 0), 120), cs = min(max(qgc - 8, 0), 48);
    const int rsw = __builtin_amdgcn_readfirstlane(rs);
    for (int j = 0; j < NT; ++j) {
        const int cur = j & 1;
        if (j + 1 < NT) SLOAD(j + 1);
        const bool active = !(kind == 1 && j >= 4 && ((krow0 + j - 4 < rsw) || (krow0 + j - 4 >= rsw + 8)));
        if (active) {
        f32x16 p0, p1;
        SBAR(); qkt(p0, p1, K_lds + cur * SHM_K, qr, r32, hi);
        if (j >= 4) {
            int hiv = hi; asm volatile("" : "+v"(hiv));
            if (kind == 0) { const int kp0 = kp00 + (j - 4) * 64;
#pragma unroll
                for (int r = 0; r < 16; ++r) { const int kpa = kp0 + crow(r, hiv), kpb = kpa + 32;
                    const bool oka = ((unsigned)kpa < (unsigned)SEQ) && (kpa - qpos <= 128) && (qpos - kpa <= 128);
                    const bool okb = ((unsigned)kpb < (unsigned)SEQ) && (kpb - qpos <= 128) && (qpos - kpb <= 128);
                    p0[r] = oka ? p0[r] : -1e30f; p1[r] = okb ? p1[r] : -1e30f; }
            } else { const int keyrow = krow0 + j - 4; const bool rowok = (keyrow >= rs) && (keyrow < rs + 8);
                const int dr = min(max(keyrow - qgr + 7, 0), 14); const LAS float* trow = tab + dr * 31;
#pragma unroll
                for (int r = 0; r < 16; ++r) { const int ka = crow(r, hiv);
                    const bool oka = rowok && ((unsigned)(ka - cs) < 16u);
                    const float ba = trow[min(max(ka - qgc + 15, 0), 30)];
                    p0[r] = oka ? p0[r] + ba : -1e30f; }
                asm volatile("" ::: "memory");
#pragma unroll
                for (int r = 0; r < 16; ++r) { const int kb2 = crow(r, hiv) + 32;
                    const bool okb = rowok && ((unsigned)(kb2 - cs) < 16u);
                    const float bb = trow[min(max(kb2 - qgc + 15, 0), 30)];
                    p1[r] = okb ? p1[r] + bb : -1e30f; }
            }
        }
        float pmax = p0[0];
#pragma unroll
        for (int r = 1; r < 16; ++r) pmax = fmaxf(pmax, p0[r]);
#pragma unroll
        for (int r = 0; r < 16; ++r) pmax = fmaxf(pmax, p1[r]);
        { auto rr = __builtin_amdgcn_permlane32_swap(__float_as_uint(pmax), __float_as_uint(pmax), false, false); pmax = fmaxf(__uint_as_float(rr[0]), __uint_as_float(rr[1])); }
        float mn, alpha;
        if (__all(pmax - m_reg <= THR)) { mn = m_reg; alpha = 1.f; }
        else { mn = fmaxf(m_reg, pmax); alpha = fast_exp2(m_reg - mn); m_reg = mn; }
#pragma unroll
        for (int r = 0; r < 16; ++r) { p0[r] = fast_exp2(p0[r] - mn); p1[r] = fast_exp2(p1[r] - mn); }
        float ps = 0.f;
#pragma unroll
        for (int r = 0; r < 16; ++r) ps += p0[r];
#pragma unroll
        for (int r = 0; r < 16; ++r) ps += p1[r];
        { auto rr = __builtin_amdgcn_permlane32_swap(__float_as_uint(ps), __float_as_uint(ps), false, false); ps = __uint_as_float(rr[0]) + __uint_as_float(rr[1]); }
        l_reg = l_reg * alpha + ps;
        bf16x8 pa0, pa1, pa2, pa3;
#define PK4(P, BASE, OUT) do { unsigned a0 = cvt_pk_bf16(P[BASE + 0], P[BASE + 1]), a1 = cvt_pk_bf16(P[BASE + 2], P[BASE + 3]); \
        unsigned b0 = cvt_pk_bf16(P[BASE + 4], P[BASE + 5]), b1 = cvt_pk_bf16(P[BASE + 6], P[BASE + 7]); \
        auto r0 = __builtin_amdgcn_permlane32_swap(a0, b0, false, false); auto r1 = __builtin_amdgcn_permlane32_swap(a1, b1, false, false); \
        u32x4 w = {r0[0], r1[0], r0[1], r1[1]}; OUT = __builtin_bit_cast(bf16x8, w); } while (0)
        PK4(p0, 0, pa0); PK4(p0, 8, pa1); PK4(p1, 0, pa2); PK4(p1, 8, pa3);
#undef PK4
        if (__any(alpha < 1.f)) { if (hi == 0) al_l[r32] = alpha; asm volatile("s_waitcnt lgkmcnt(0)" ::: "memory");
#pragma unroll
            for (int d = 0; d < 4; ++d)
#pragma unroll
                for (int r = 0; r < 16; ++r) o[d][r] *= al_l[crow(r, hi)]; }
        SBAR();
        { const int vb = vb0 + cur * SHM_V; pv_one<0>(o[0], vb, pa0, pa1, pa2, pa3); pv_one<1>(o[1], vb, pa0, pa1, pa2, pa3); pv_one<2>(o[2], vb, pa0, pa1, pa2, pa3); pv_one<3>(o[3], vb, pa0, pa1, pa2, pa3); }
        }
        if (j + 1 < NT) SWRITE((j + 1) & 1);
        __syncthreads();
    }
    if (hi == 0) li_l[r32] = l_reg;
    asm volatile("s_waitcnt lgkmcnt(0)" ::: "memory");
    bf16* Ow = YC + (size_t)qrow0 * DM + ocol + r32;
    int hie = hi; asm volatile("" : "+v"(hie));
#pragma unroll
    for (int r = 0; r < 16; ++r) { const int orow = crow(r, hie); const float rl = fast_rcp(li_l[orow]);
#pragma unroll
        for (int d0 = 0; d0 < 4; ++d0) { const float v = o[d0][r] * rl; Ow[(size_t)orow * DM + d0 * 32] = (bf16)(cvt_pk_bf16(v, v) & 0xffffu); } }
#undef SLOAD
#undef SWRITE
#undef GROW
}
}

struct Args { const float* in[22]; float* out; unsigned char* ws; int ph_lo, ph_hi; };

struct Frame {
    LAS unsigned char* lds; int tid, lane, wave, G, c;
    unsigned char* ws;
    const float *x, *cvec, *ctx, *c_ctx, *w_mod, *b_mod, *g_mix, *w_in, *a_sink, *na_rpb, *w_pool, *pool_scale, *w_fnet, *w_branch, *w_out, *g_ffn, *w_ff_gate, *w_ff_val, *ff_conv_w, *ff_conv_b, *w_ff_down, *g_final;
    float* out;
};

__device__ __forceinline__ int map_row(int kind, int n) {
    if (kind == 1) { if (n < 1280) { const int head = n >> 7, d = n & 127, hf = d >> 6, i = d & 63; const int p = (i < 32) ? 2 * i : 2 * (i - 32) + 1; return head * 128 + hf * 64 + p; } return n; }
    if (kind == 2) return (n >> 7) * 256 + (n & 127);
    if (kind == 3) return (n >> 7) * 256 + 128 + (n & 127);
    return n;
}
__device__ __forceinline__ void tr_item(const float* __restrict__ W, int ldw, int nblk, int item, bf16* __restrict__ WT, int ldt, int kofs, int mapkind, const float* __restrict__ kscale, LAS float* scr, int lane, unsigned* cmax = nullptr, int cbase = 0) {
    const int kb = item / nblk, nb = item - kb * nblk, k0 = 64 * kb, n0 = 32 * nb;
    float wv[32];
#pragma unroll
    for (int i = 0; i < 32; ++i) { const int kk = 2 * i + (lane >> 5); wv[i] = W[(size_t)(k0 + kk) * ldw + n0 + (lane & 31)]; }
    if (kscale) {
#pragma unroll
        for (int i = 0; i < 32; ++i) wv[i] *= kscale[k0 + 2 * i + (lane >> 5)]; }
    if (cmax != nullptr && n0 >= cbase) {
        float mx = 0.f;
#pragma unroll
        for (int i = 0; i < 32; ++i) mx = fmaxf(mx, fabsf(wv[i]));
        mx = fmaxf(mx, __shfl_xor(mx, 32));
        if (lane < 32) atomicMax(cmax + (n0 - cbase) + lane, __float_as_uint(mx));
    }
#pragma unroll
    for (int i = 0; i < 32; ++i) { const int kk = 2 * i + (lane >> 5); scr[kk * 33 + (lane & 31)] = wv[i]; }
    LDS_WAIT(); asm volatile("" ::: "memory");
    const int cch = lane & 7;
#pragma unroll
    for (int j = 0; j < 4; ++j) { const int n = (lane >> 3) + 8 * j; const LAS float* s = scr + (8 * cch) * 33 + n;
        u32x4 o; o.x = cvt_pk_bf16(s[0 * 33], s[1 * 33]); o.y = cvt_pk_bf16(s[2 * 33], s[3 * 33]); o.z = cvt_pk_bf16(s[4 * 33], s[5 * 33]); o.w = cvt_pk_bf16(s[6 * 33], s[7 * 33]);
        *(u32x4*)(WT + (size_t)map_row(mapkind, n0 + n) * ldt + kofs + k0 + 8 * cch) = o; }
    LDS_WAIT(); asm volatile("" ::: "memory");
}

__device__ __forceinline__ void phase_prologue(Frame& F, bool do_mod) {
    const int gw = F.c * NWAVES + F.wave, NGW = F.G * NWAVES, lane = F.lane;
    unsigned char* ws = F.ws;
    LAS float* sv = (LAS float*)(F.lds + 73728);
    for (int i = F.tid; i < 3 * DM; i += NWAVES * 64) { const int v = i / DM, k = i - v * DM; const float cc = v < 2 ? F.cvec[v * DM + k] : F.c_ctx[k]; sv[i] = cc * sigmoidf_(cc); }
    __syncthreads();
    float* MOD = (float*)(ws + WS_MOD);
    if (do_mod) for (int it = F.wave * F.G + F.c; it < 2 * 96 * 16; it += NGW) {
        const int l = it / (96 * 16), r = it - l * 96 * 16, cbk = r >> 4, kc = r & 15;
        const int col = cbk * 256 + lane * 4, k0 = kc * 256;
        const float* Wp = F.w_mod + (size_t)l * DM * MODW + (size_t)k0 * MODW + col;
        f32x4 a0 = {0.f, 0.f, 0.f, 0.f}, a1 = a0, a2 = a0;
#pragma unroll 8
        for (int k = 0; k < 256; ++k) { const f32x4 w = *(const f32x4*)(Wp + (size_t)k * MODW); const float s0 = sv[k0 + k], s1 = sv[DM + k0 + k], s2 = sv[2 * DM + k0 + k]; a0 += w * s0; a1 += w * s1; a2 += w * s2; }
        if (kc == 0) { const f32x4 bb = *(const f32x4*)(F.b_mod + (size_t)l * MODW + col); a0 += bb; a1 += bb; a2 += bb; }
        float* pp = (float*)(ws + WS_PART) + ((size_t)(l * 16 + kc) * 3) * MODW + col;
        *(f32x4*)pp = a0; *(f32x4*)(pp + MODW) = a1; *(f32x4*)(pp + 2 * MODW) = a2;
    }
    { float* rope = (float*)(ws + WS_ROPE);
      for (int i = gw * 64 + lane; i < 128 * 32; i += NGW * 64) { const int pos = i >> 5, fi = i & 31; const float inv = exp2f(-(float)fi * (13.287712379549449f / 32.0f)); float sn, cs; sincosf((float)pos * inv, &sn, &cs); rope[2 * i] = cs; rope[2 * i + 1] = sn; }
      bf16* tab1 = (bf16*)(ws + WS_TAB1);
      for (int i = gw * 64 + lane; i < 512 * 256; i += NGW * 64) { const int mp = i >> 8, cc = i & 255, part = mp >> 8, m = mp & 255; const float xr = (float)((m * cc) & 255) * (1.0f / 256.0f);
          const float v = part ? -__builtin_amdgcn_sinf(xr) : __builtin_amdgcn_cosf(xr); tab1[i] = (bf16)(cvt_pk_bf16(v * 0.0625f, 0.f) & 0xffffu); }
      bf16* dftc = (bf16*)(ws + WS_DFTC);
      for (int i = gw * 64 + lane; i < 256 * 512; i += NGW * 64) { const int k = i >> 9, cc = i & 511, part = cc >> 8, n = cc & 255; const float xr = (float)((k * n) & 255) * (1.0f / 256.0f);
          const float v = part ? __builtin_amdgcn_sinf(xr) : __builtin_amdgcn_cosf(xr); dftc[i] = (bf16)(cvt_pk_bf16(v * 0.0625f, 0.f) & 0xffffu); }
      bf16* dfta = (bf16*)(ws + WS_DFTA);
      const float sc = 0.011048543456039806f;
      for (int k = 1 + gw; k <= SEQ / 4; k += NGW) { bf16* rowp = dfta + (size_t)k * pg8::ZK;
          for (int s = 0; s < 16; ++s) { const int c0 = s * 512 + lane * 8; float v[8];
#pragma unroll
              for (int e = 0; e < 8; ++e) { const int cc = c0 + e, blk = cc >> 11, n = 2 * (cc & 2047) + (blk & 1); const float xr = (float)((k * n) & 8191) * (1.0f / 8192.0f);
                  v[e] = ((blk < 2) ? __builtin_amdgcn_cosf(xr) : __builtin_amdgcn_sinf(xr)) * sc; }
              u32x4 w; w.x = cvt_pk_bf16(v[0], v[1]); w.y = cvt_pk_bf16(v[2], v[3]); w.z = cvt_pk_bf16(v[4], v[5]); w.w = cvt_pk_bf16(v[6], v[7]); *(u32x4*)(rowp + c0) = w; } }
    }
    { f32x4* xd = (f32x4*)(ws + WS_X + (size_t)TL * DM * 4); const f32x4* xs = (const f32x4*)F.ctx; _Pragma("unroll 4") for (size_t i = (size_t)gw * 64 + lane; i < (size_t)TC * DM / 4; i += (size_t)NGW * 64) xd[i] = xs[i]; }
    { bf16* wp = (bf16*)(ws + WS_WPOOLB); for (size_t i = (size_t)gw * 64 + lane; i < (size_t)2 * 4 * 256 * 256; i += (size_t)NGW * 64) wp[i] = (bf16)(cvt_pk_bf16(F.w_pool[i], 0.f) & 0xffffu);
      bf16* wf = (bf16*)(ws + WS_WFNETB); for (size_t i = (size_t)gw * 64 + lane; i < (size_t)2 * 1024 * 1024; i += (size_t)NGW * 64) wf[i] = (bf16)(cvt_pk_bf16(F.w_fnet[i], 0.f) & 0xffffu); }
    LAS float* scr = (LAS float*)(F.lds + F.wave * 8704);
    constexpr int I_IN = 64 * 720, I_BR = 16 * 128, I_OUT = 64 * 128, I_UP = 64 * 344, I_DN = 172 * 128;
    constexpr int I_LAYER = I_IN + 4 * I_BR + I_OUT + 2 * I_UP + I_DN;
    for (int it = gw; it < 2 * I_LAYER; it += NGW) {
        const int l = it / I_LAYER; int r = it - l * I_LAYER;
        unsigned char* wl = ws + WS_WL + (size_t)l * WL_STRIDE;
        if (r < I_IN) { tr_item(F.w_in + (size_t)l * DM * NIN, NIN, 720, r, (bf16*)(wl + WL_IN), DM, 0, 1, nullptr, scr, lane, (unsigned*)(ws + WS_CM) + l * 16384, 6656); continue; } r -= I_IN;
        if (r < I_BR) { tr_item(F.w_branch + ((size_t)l * 4 + 0) * 1024 * DM, DM, 128, r, (bf16*)(wl + WL_M), DM, 0, 0, nullptr, scr, lane); continue; } r -= I_BR;
        if (r < I_BR) { tr_item(F.w_branch + ((size_t)l * 4 + 1) * 1024 * DM, DM, 128, r, (bf16*)(wl + WL_M), DM, 1024, 0, nullptr, scr, lane); continue; } r -= I_BR;
        if (r < I_BR) { tr_item(F.w_branch + ((size_t)l * 4 + 2) * 1024 * DM, DM, 128, r, (bf16*)(ws + WS_WB2ST) + (size_t)l * DM * 1024, 1024, 0, 0, F.pool_scale + l * 1024, scr, lane); continue; } r -= I_BR;
        if (r < I_BR) { tr_item(F.w_branch + ((size_t)l * 4 + 3) * 1024 * DM, DM, 128, r, (bf16*)(ws + WS_WB3T) + (size_t)l * DM * 1024, 1024, 0, 0, nullptr, scr, lane); continue; } r -= I_BR;
        if (r < I_OUT) { tr_item(F.w_out + (size_t)l * DM * DM, DM, 128, r, (bf16*)(wl + WL_OUT), DM, 0, 0, nullptr, scr, lane); continue; } r -= I_OUT;
        if (r < I_UP) { tr_item(F.w_ff_gate + (size_t)l * DM * DFF, DFF, 344, r, (bf16*)(wl + WL_UP), DM, 0, 2, nullptr, scr, lane, (unsigned*)(ws + WS_CM2) + l * DFF, 0); continue; } r -= I_UP;
        if (r < I_UP) { tr_item(F.w_ff_val + (size_t)l * DM * DFF, DFF, 344, r, (bf16*)(wl + WL_UP), DM, 0, 3, nullptr, scr, lane, (unsigned*)(ws + WS_CM3) + l * DFF, 0); continue; } r -= I_UP;
        tr_item(F.w_ff_down + (size_t)l * DFF * DM, DM, 128, r, (bf16*)(wl + WL_DN), DFF, 0, 0, nullptr, scr, lane);
    }
}

__device__ __forceinline__ float mod_from_parts(const float* __restrict__ part, int l, int v, int idx) {
    float s = 0.f;
#pragma unroll
    for (int kc = 0; kc < 16; ++kc) s += part[((size_t)(l * 16 + kc) * 3 + v) * MODW + idx];
    return s;
}
__device__ __forceinline__ void norm_rows(Frame& F, const float* __restrict__ src_lat, const float* src_ctx, const float* __restrict__ gvec, const float* __restrict__ modl, int sh_off, int sc_off, bf16* __restrict__ H, int nrows, const float* __restrict__ slab, float* xctx_out, unsigned* __restrict__ H8, float* __restrict__ SHs, const float* __restrict__ part = nullptr, int part_l = 0) {
    const int gw = F.wave * F.G + F.c, NGW = F.G * NWAVES, lane = F.lane;
    LAS float* LA = (LAS float*)F.lds;
    for (int i = F.tid; i < 3 * DM; i += NWAVES * 64) { const int v = i / DM, k = i - v * DM;
        const float sc = part ? mod_from_parts(part, part_l, v, sc_off + k) : modl[(size_t)v * MODW + sc_off + k], sh = part ? mod_from_parts(part, part_l, v, sh_off + k) : modl[(size_t)v * MODW + sh_off + k];
        LA[i] = gvec[k] * (sc + 1.0f); LA[3 * DM + i] = sh; }
    __syncthreads();
    if (gw < nrows) {
        f32x4 v[16];
        { const float* xr = (gw < TL ? src_lat + (size_t)gw * DM : src_ctx + (size_t)(gw - TL) * DM) + lane * 4;
#pragma unroll
          for (int j = 0; j < 16; ++j) v[j] = *(const f32x4*)(xr + 256 * j); }
        for (int row = gw; row < nrows; row += NGW) {
            const int nrow = row + NGW; f32x4 vn[16];
            if (nrow < nrows) { const float* xr = (nrow < TL ? src_lat + (size_t)nrow * DM : src_ctx + (size_t)(nrow - TL) * DM) + lane * 4;
#pragma unroll
                for (int j = 0; j < 16; ++j) vn[j] = *(const f32x4*)(xr + 256 * j); }
            if (slab != nullptr && row >= TL) {
                const float* sp = slab + (size_t)(row - TL) * DM + lane * 4;
#pragma unroll
                for (int p = 0; p < 8; ++p)
#pragma unroll
                    for (int j = 0; j < 16; ++j) v[j] += *(const f32x4*)(sp + (size_t)p * TC * DM + 256 * j);
                float* xo = xctx_out + (size_t)(row - TL) * DM + lane * 4;
#pragma unroll
                for (int j = 0; j < 16; ++j) *(f32x4*)(xo + 256 * j) = v[j];
            }
            float ss = 0.f;
#pragma unroll
            for (int j = 0; j < 16; ++j) ss += (v[j][0] * v[j][0] + v[j][1] * v[j][1]) + (v[j][2] * v[j][2] + v[j][3] * v[j][3]);
            const float rstd = rsqrtf(wave_sum(ss) * (1.0f / DM) + EPS);
            const int var = row < SEQ ? 0 : (row < TL ? 1 : 2);
            const LAS float* pa = LA + var * DM + lane * 4; const LAS float* pb = pa + 3 * DM;
            bf16* hp = H + (size_t)row * DM + lane * 4;
            float amax = 0.f;
#pragma unroll
            for (int j = 0; j < 16; ++j) { const f32x4 a = *(const LAS f32x4*)(pa + 256 * j), b = *(const LAS f32x4*)(pb + 256 * j);
                const f32x4 y = v[j] * rstd * a + b; if (H != nullptr) { u32x2 w; w.x = cvt_pk_bf16(y[0], y[1]); w.y = cvt_pk_bf16(y[2], y[3]); *(u32x2*)(hp + 256 * j) = w; }
                v[j] = y; amax = fmaxf(fmaxf(amax, fmaxf(fabsf(y[0]), fabsf(y[1]))), fmaxf(fabsf(y[2]), fabsf(y[3]))); }
            if (H8 != nullptr) {
#pragma unroll
                for (int o = 1; o < 64; o <<= 1) amax = fmaxf(amax, __shfl_xor(amax, o));
                amax = fmaxf(amax, 1e-20f); const float qs = 127.0f / amax;
                if (lane == 0) SHs[row] = amax * (1.0f / 127.0f);
                unsigned* qp = H8 + (size_t)row * (DM / 4) + lane;
#pragma unroll
                for (int j = 0; j < 16; ++j) { const int q0 = (int)__builtin_rintf(v[j][0] * qs), q1 = (int)__builtin_rintf(v[j][1] * qs), q2 = (int)__builtin_rintf(v[j][2] * qs), q3 = (int)__builtin_rintf(v[j][3] * qs);
                    qp[64 * j] = (unsigned)(q0 & 0xff) | ((unsigned)(q1 & 0xff) << 8) | ((unsigned)(q2 & 0xff) << 16) | ((unsigned)(q3 & 0xff) << 24); }
            }
            if (nrow < nrows) {
#pragma unroll
                for (int j = 0; j < 16; ++j) v[j] = vn[j]; }
        }
    }
    __syncthreads();
}
__device__ __forceinline__ void final_norm(Frame& F, const float* __restrict__ X) {
    const int gw = F.c * NWAVES + F.wave, NGW = F.G * NWAVES, lane = F.lane;
    f32x4 g[16];
#pragma unroll
    for (int j = 0; j < 16; ++j) g[j] = *(const f32x4*)(F.g_final + lane * 4 + 256 * j);
    if (gw < TL) {
        f32x4 v[16];
        { const float* xr = X + (size_t)gw * DM + lane * 4;
#pragma unroll
          for (int j = 0; j < 16; ++j) v[j] = *(const f32x4*)(xr + 256 * j); }
        for (int row = gw; row < TL; row += NGW) {
            const int nrow = row + NGW; f32x4 vn[16];
            if (nrow < TL) { const float* xr = X + (size_t)nrow * DM + lane * 4;
#pragma unroll
                for (int j = 0; j < 16; ++j) vn[j] = *(const f32x4*)(xr + 256 * j); }
            float ss = 0.f;
#pragma unroll
            for (int j = 0; j < 16; ++j) ss += (v[j][0] * v[j][0] + v[j][1] * v[j][1]) + (v[j][2] * v[j][2] + v[j][3] * v[j][3]);
            const float rstd = rsqrtf(wave_sum(ss) * (1.0f / DM) + EPS);
            float* __restrict__ op = F.out + (size_t)row * DM + lane * 4;
#pragma unroll
            for (int j = 0; j < 16; ++j) *(f32x4*)(op + 256 * j) = v[j] * rstd * g[j];
            if (nrow < TL) {
#pragma unroll
                for (int j = 0; j < 16; ++j) v[j] = vn[j]; }
        }
    }
}
__device__ __forceinline__ void pool_diff(Frame& F, const bf16* __restrict__ ACT, bf16* __restrict__ YC, int nrows) {
    const size_t nth = (size_t)F.G * NWAVES * 64, t0 = (size_t)(F.c * NWAVES + F.wave) * 64 + F.lane;
    for (size_t i = t0; i < (size_t)nrows * 128; i += nth) {
        const int row = (int)(i >> 7), ch = (int)(i & 127) * 8, g = ch >> 8, w = 2 << g;
        int t, n; if (row < TL) { t = row & (SEQ - 1); n = SEQ; } else { t = (row - TL) & 255; n = CTXL; }
        const int base = row - t;
        const int lo = max(t - w / 2, 0), hi = min(t + w / 2, n);
        u32x4 a[16];
#pragma unroll
        for (int q = 0; q < 16; ++q) { const int tq = min(lo + q, n - 1); a[q] = *(const u32x4*)(ACT + (size_t)(base + tq) * ACTW + OFF_PU + ch); }
        const u32x4 c = *(const u32x4*)(ACT + (size_t)row * ACTW + OFF_PU + ch);
        float s[8] = {0.f, 0.f, 0.f, 0.f, 0.f, 0.f, 0.f, 0.f};
#pragma unroll
        for (int q = 0; q < 16; ++q) { const float wq = (lo + q < hi) ? 1.0f : 0.0f;
            s[0] += wq * bflo(a[q].x); s[1] += wq * bfhi(a[q].x); s[2] += wq * bflo(a[q].y); s[3] += wq * bfhi(a[q].y); s[4] += wq * bflo(a[q].z); s[5] += wq * bfhi(a[q].z); s[6] += wq * bflo(a[q].w); s[7] += wq * bfhi(a[q].w); }
        const float inv = 1.0f / (float)(hi - lo);
        u32x4 o; o.x = cvt_pk_bf16(s[0] * inv - bflo(c.x), s[1] * inv - bfhi(c.x)); o.y = cvt_pk_bf16(s[2] * inv - bflo(c.y), s[3] * inv - bfhi(c.y));
        o.z = cvt_pk_bf16(s[4] * inv - bflo(c.z), s[5] * inv - bfhi(c.z)); o.w = cvt_pk_bf16(s[6] * inv - bflo(c.w), s[7] * inv - bfhi(c.w));
        *(u32x4*)(YC + (size_t)row * DM + 2048 + ch) = o;
    }
}

__device__ __forceinline__ void quant_gate_weights(Frame& F) {
    const int gw = F.c * NWAVES + F.wave, NGW = F.G * NWAVES, lane = F.lane;
    unsigned char* ws = F.ws;
    auto up_row = [&](int it) {
        const int l = it / NUP, ri = it - l * NUP, j = (ri >> 8) * 128 + (ri & 127); const bool isval = (ri & 255) >= 128;
        const float cm = fmaxf(__uint_as_float(((const unsigned*)(ws + (isval ? WS_CM3 : WS_CM2)))[l * DFF + j]), 1e-30f), qs = 127.0f / cm;
        if (lane == 0) ((float*)(ws + WS_SWUP))[it] = cm * (1.0f / 127.0f);
        const bf16* src = (const bf16*)(ws + WS_WL + (size_t)l * WL_STRIDE + WL_UP) + (size_t)ri * DM + lane * 8;
        u32x2* dst = (u32x2*)(ws + (l == 0 ? WS_WV8 : WS_WGA8) + (size_t)ri * DM) + lane;
        u32x4 a[8];
#pragma unroll
        for (int jj = 0; jj < 8; ++jj) a[jj] = *(const u32x4*)(src + 512 * jj);
#pragma unroll
        for (int jj = 0; jj < 8; ++jj) { const float f[8] = {bflo(a[jj].x), bfhi(a[jj].x), bflo(a[jj].y), bfhi(a[jj].y), bflo(a[jj].z), bfhi(a[jj].z), bflo(a[jj].w), bfhi(a[jj].w)}; unsigned q[8];
#pragma unroll
            for (int e = 0; e < 8; ++e) q[e] = (unsigned)((int)__builtin_rintf(fminf(fmaxf(f[e] * qs, -127.f), 127.f)) & 0xff);
            u32x2 w; w.x = q[0] | (q[1] << 8) | (q[2] << 16) | (q[3] << 24); w.y = q[4] | (q[5] << 8) | (q[6] << 16) | (q[7] << 24); dst[64 * jj] = w; }
    };
    if (F.G == 256) {
        if (F.c >= 128) for (int it = gw - 1024; it < 8192; it += 1024) up_row(it);
        for (int it = 8192 + gw; it < 2 * NUP; it += NGW) up_row(it);
    } else for (int it = gw; it < 2 * NUP; it += NGW) up_row(it);
    for (int it = gw; it < 2 * 16384; it += NGW) {
        const int l = it >> 14, n = it & 16383;
        const float cm = fmaxf(__uint_as_float(((const unsigned*)(ws + WS_CM))[it]), 1e-30f), qs = 127.0f / cm;
        if (lane == 0) ((float*)(ws + WS_SW))[it] = cm * (1.0f / 127.0f);
        const bf16* src = (const bf16*)(ws + WS_WL + (size_t)l * WL_STRIDE + WL_IN) + (size_t)(6656 + n) * DM + lane * 8;
        u32x2* dst = (u32x2*)(ws + WS_WG8 + ((size_t)l * 16384 + n) * DM) + lane;
        u32x4 a[8];
#pragma unroll
        for (int j = 0; j < 8; ++j) a[j] = *(const u32x4*)(src + 512 * j);
#pragma unroll
        for (int j = 0; j < 8; ++j) { const float f[8] = {bflo(a[j].x), bfhi(a[j].x), bflo(a[j].y), bfhi(a[j].y), bflo(a[j].z), bfhi(a[j].z), bflo(a[j].w), bfhi(a[j].w)}; unsigned q[8];
#pragma unroll
            for (int e = 0; e < 8; ++e) q[e] = (unsigned)((int)__builtin_rintf(fminf(fmaxf(f[e] * qs, -127.f), 127.f)) & 0xff);
            u32x2 w; w.x = q[0] | (q[1] << 8) | (q[2] << 16) | (q[3] << 24); w.y = q[4] | (q[5] << 8) | (q[6] << 16) | (q[7] << 24); dst[64 * j] = w; }
    }
}

__device__ __forceinline__ void dft_specials(Frame& F, const bf16* __restrict__ ZT, bf16* __restrict__ YC, float* __restrict__ E4, const bf16* __restrict__ ACT, const bf16* __restrict__ TAB1) {
    const int gw = F.c * NWAVES + F.wave, NGW = F.G * NWAVES, lane = F.lane;
    for (int it = gw; it < 8 * 256; it += NGW) {
        const int z = it >> 8, ch = it & 255, b = z >> 2, g = z & 3;
        const bf16* zr = ZT + ((size_t)z * 256 + ch) * pg8::ZK;
        u32x4 ve[4], vo[4];
#pragma unroll
        for (int j = 0; j < 4; ++j) { ve[j] = *(const u32x4*)(zr + (size_t)(j * 64 + lane) * 8); vo[j] = *(const u32x4*)(zr + 2048 + (size_t)(j * 64 + lane) * 8); }
        float e4;
        { const unsigned* up = (const unsigned*)(ACT + (size_t)(b * SEQ + SEQ / 2) * ACTW + OFF_FU + g * 256) + lane * 2; const unsigned* tp = (const unsigned*)(TAB1 + (size_t)ch * 256) + lane * 2;
          const unsigned u0 = up[0], u1 = up[1], t0 = tp[0], t1 = tp[1];
          e4 = wave_sum((bflo(u0) * bflo(t0) + bfhi(u0) * bfhi(t0)) + (bflo(u1) * bflo(t1) + bfhi(u1) * bfhi(t1))); }
        float se = 0.f, so = 0.f;
#pragma unroll
        for (int j = 0; j < 4; ++j) { se += (bflo(ve[j].x) + bfhi(ve[j].x)) + (bflo(ve[j].y) + bfhi(ve[j].y)) + (bflo(ve[j].z) + bfhi(ve[j].z)) + (bflo(ve[j].w) + bfhi(ve[j].w));
            so += (bflo(vo[j].x) + bfhi(vo[j].x)) + (bflo(vo[j].y) + bfhi(vo[j].y)) + (bflo(vo[j].z) + bfhi(vo[j].z)) + (bflo(vo[j].w) + bfhi(vo[j].w)); }
        se = wave_sum(se) + e4; so = wave_sum(so);
        if (lane == 0) { const float sc = 0.011048543456039806f; bf16* yb = YC + (size_t)b * SEQ * DM + 3072 + g * 256 + ch;
            yb[0] = (bf16)(cvt_pk_bf16((se + so) * sc, 0.f) & 0xffffu); yb[(size_t)(SEQ / 2) * DM] = (bf16)(cvt_pk_bf16((se - so) * sc, 0.f) & 0xffffu); E4[it] = e4 * sc; }
    }
}
__device__ __forceinline__ void dft_combine(Frame& F, const float* __restrict__ CS, const float* __restrict__ E4, bf16* __restrict__ YC) {
    const int gw = F.c * NWAVES + F.wave, NGW = F.G * NWAVES, lane = F.lane;
    const size_t PS = (size_t)8 * 2048 * 256;
    const size_t nth = (size_t)NGW * 64, t0 = (size_t)gw * 64 + lane, NI = (size_t)8 * 2048 * 32;
    for (size_t i = t0; i < NI; i += nth) {
        const int ch = (int)(i & 31) * 8, r = (int)(i >> 5) & 2047, z = (int)(i >> 16), b = z >> 2, g = z & 3, k = r + 1;
        const size_t so = ((size_t)z * 2048 + r) * 256 + ch;
        f32x4 v[4][2], e[2];
#pragma unroll
        for (int p = 0; p < 4; ++p) { v[p][0] = *(const f32x4*)(CS + p * PS + so); v[p][1] = *(const f32x4*)(CS + p * PS + so + 4); }
        e[0] = *(const f32x4*)(E4 + z * 256 + ch); e[1] = *(const f32x4*)(E4 + z * 256 + ch + 4);
        const float sg = (k & 1) ? -1.0f : 1.0f;
        u32x4 o[4];
        { f32x4 a1[2], a2[2], b1[2], b2[2];
#pragma unroll
          for (int h = 0; h < 2; ++h) { const f32x4 q = e[h] * sg; a1[h] = v[0][h] + v[1][h] + q; a2[h] = v[0][h] - v[1][h] + q; b1[h] = v[2][h] + v[3][h]; b2[h] = v[3][h] - v[2][h]; }
          const f32x4 y0[2] = {a1[0] + b1[0], a1[1] + b1[1]}, y1[2] = {a1[0] - b1[0], a1[1] - b1[1]}, y2[2] = {a2[0] + b2[0], a2[1] + b2[1]}, y3[2] = {a2[0] - b2[0], a2[1] - b2[1]};
          o[0].x = cvt_pk_bf16(y0[0][0], y0[0][1]); o[0].y = cvt_pk_bf16(y0[0][2], y0[0][3]); o[0].z = cvt_pk_bf16(y0[1][0], y0[1][1]); o[0].w = cvt_pk_bf16(y0[1][2], y0[1][3]);
          o[1].x = cvt_pk_bf16(y1[0][0], y1[0][1]); o[1].y = cvt_pk_bf16(y1[0][2], y1[0][3]); o[1].z = cvt_pk_bf16(y1[1][0], y1[1][1]); o[1].w = cvt_pk_bf16(y1[1][2], y1[1][3]);
          o[2].x = cvt_pk_bf16(y2[0][0], y2[0][1]); o[2].y = cvt_pk_bf16(y2[0][2], y2[0][3]); o[2].z = cvt_pk_bf16(y2[1][0], y2[1][1]); o[2].w = cvt_pk_bf16(y2[1][2], y2[1][3]);
          o[3].x = cvt_pk_bf16(y3[0][0], y3[0][1]); o[3].y = cvt_pk_bf16(y3[0][2], y3[0][3]); o[3].z = cvt_pk_bf16(y3[1][0], y3[1][1]); o[3].w = cvt_pk_bf16(y3[1][2], y3[1][3]); }
        bf16* yb = YC + (size_t)b * SEQ * DM + 3072 + g * 256 + ch;
        *(u32x4*)(yb + (size_t)k * DM) = o[0];
        *(u32x4*)(yb + (size_t)(SEQ - k) * DM) = o[1];
        if (k < SEQ / 4) { *(u32x4*)(yb + (size_t)(SEQ / 2 - k) * DM) = o[2]; *(u32x4*)(yb + (size_t)(SEQ / 2 + k) * DM) = o[3]; }
    }
}

__device__ __forceinline__ void up_tail_rows(Frame& F, const unsigned char* __restrict__ H8, const float* __restrict__ SH, const unsigned char* __restrict__ W8, const float* __restrict__ SWl,
                                             const float* __restrict__ cw, const float* __restrict__ cb, bf16* __restrict__ U) {
    const int gw = F.wave * F.G + F.c, NGW = F.G * NWAVES, lane = F.lane;
    constexpr int R0 = TL - 5;
    u32x4 h[5][4];
#pragma unroll
    for (int r = 0; r < 5; ++r)
#pragma unroll
        for (int q = 0; q < 4; ++q) h[r][q] = *(const u32x4*)(H8 + (size_t)(R0 + r) * DM + q * 1024 + lane * 16);
    float sh[5];
#pragma unroll
    for (int r = 0; r < 5; ++r) sh[r] = SH[R0 + r];
    for (int ch = gw; ch < DFF; ch += NGW) {
        const int rg = (ch >> 7) * 256 + (ch & 127), rv = rg + 128;
        u32x4 wg[4], wv[4];
#pragma unroll
        for (int q = 0; q < 4; ++q) { wg[q] = *(const u32x4*)(W8 + (size_t)rg * DM + q * 1024 + lane * 16); wv[q] = *(const u32x4*)(W8 + (size_t)rv * DM + q * 1024 + lane * 16); }
        int ag[5] = {0, 0, 0, 0, 0}, av[4] = {0, 0, 0, 0};
#pragma unroll
        for (int q = 0; q < 4; ++q)
#pragma unroll
            for (int e = 0; e < 4; ++e) {
#pragma unroll
                for (int r = 0; r < 5; ++r) ag[r] = __builtin_amdgcn_sdot4((int)h[r][q][e], (int)wg[q][e], ag[r], false);
#pragma unroll
                for (int r = 0; r < 4; ++r) av[r] = __builtin_amdgcn_sdot4((int)h[r + 1][q][e], (int)wv[q][e], av[r], false);
            }
#pragma unroll
        for (int o = 32; o >= 1; o >>= 1) {
#pragma unroll
            for (int r = 0; r < 5; ++r) ag[r] += __shfl_xor(ag[r], o);
#pragma unroll
            for (int r = 0; r < 4; ++r) av[r] += __shfl_xor(av[r], o);
        }
        if (lane == 0) {
            const float sg = SWl[rg], sv = SWl[rv], w0 = cw[ch], w1 = cw[DFF + ch], w2 = cw[2 * DFF + ch], b = cb[ch];
            float a[5];
#pragma unroll
            for (int r = 0; r < 5; ++r) a[r] = (float)ag[r] * sh[r] * sg;
#pragma unroll
            for (int r = 0; r < 4; ++r) { const float nx = (r < 3) ? a[r + 2] : 0.f;
                const float x = w0 * a[r] + w1 * a[r + 1] + w2 * nx + b, v = (float)av[r] * sh[r + 1] * sv;
                U[(size_t)(R0 + 1 + r) * DFF + ch] = (bf16)(cvt_pk_bf16(x * sigmoidf_(x) * v, 0.f) & 0xffffu); }
        }
    }
}

__device__ __forceinline__ void merge_ctx_sum(Frame& F, const float* __restrict__ slab, bf16* __restrict__ MG) {
    const size_t nth = (size_t)F.G * NWAVES * 64, t0 = (size_t)(F.c * NWAVES + F.wave) * 64 + F.lane, NI = (size_t)TC * DM / 8;
    for (size_t i = t0; i < NI; i += nth) {
        f32x4 a0 = *(const f32x4*)(slab + i * 8), a1 = *(const f32x4*)(slab + i * 8 + 4);
        f32x4 v[7][2];
#pragma unroll
        for (int p = 1; p < 8; ++p) { v[p - 1][0] = *(const f32x4*)(slab + (size_t)p * TC * DM + i * 8); v[p - 1][1] = *(const f32x4*)(slab + (size_t)p * TC * DM + i * 8 + 4); }
#pragma unroll
        for (int p = 0; p < 7; ++p) { a0 += v[p][0]; a1 += v[p][1]; }
        u32x4 w; w.x = cvt_pk_bf16(a0[0], a0[1]); w.y = cvt_pk_bf16(a0[2], a0[3]); w.z = cvt_pk_bf16(a1[0], a1[1]); w.w = cvt_pk_bf16(a1[2], a1[3]);
        *(u32x4*)(MG + (size_t)TL * DM + i * 8) = w;
    }
}

constexpr int N_PHASES = 24;
typedef const char __attribute__((address_space(4)))* kptr_t;
__device__ __forceinline__ void make_frame(Frame& F, unsigned char* lds_raw) {
    kptr_t kp = (kptr_t)__builtin_amdgcn_kernarg_segment_ptr(); asm volatile("" : "+s"(kp));
    int tid = threadIdx.x; asm volatile("" : "+v"(tid));
    F.lds = (LAS unsigned char*)lds_raw;
    F.tid = tid; F.lane = tid & 63; F.wave = __builtin_amdgcn_readfirstlane(tid >> 6);
    F.G = gridDim.x; F.c = blockIdx.x;
#define KA(i) (*(const float* const __attribute__((address_space(4)))*)(kp + 8 * (i)))
    F.x = KA(0); F.cvec = KA(1); F.ctx = KA(2); F.c_ctx = KA(3); F.w_mod = KA(4); F.b_mod = KA(5); F.g_mix = KA(6); F.w_in = KA(7);
    F.a_sink = KA(8); F.na_rpb = KA(9); F.w_pool = KA(10); F.pool_scale = KA(11); F.w_fnet = KA(12); F.w_branch = KA(13); F.w_out = KA(14);
    F.g_ffn = KA(15); F.w_ff_gate = KA(16); F.w_ff_val = KA(17); F.ff_conv_w = KA(18); F.ff_conv_b = KA(19); F.w_ff_down = KA(20); F.g_final = KA(21);
    F.out = (float*)KA(22); F.ws = (unsigned char*)KA(23);
#undef KA
}
static_assert(WS_DFTA + (size_t)SEQ * pg8::ZK * 2 <= WS_WV8 && WS_WV8 + (size_t)2 * DFF * DM <= WS_WL, "WV8 sits behind DFTA");
static_assert(sizeof(Args) == 200, "Args layout: in[22] at 0, out at 176, ws at 184, ph_lo 192, ph_hi 196");

__global__ void __launch_bounds__(NWAVES * 64, 2) fwd(Args args) {
    extern __shared__ __attribute__((aligned(16))) unsigned char lds_raw[];
    {   LAS unsigned char* l3 = (LAS unsigned char*)lds_raw;
        for (int u = threadIdx.x; u < (LDS_BYTES - LDSCTL_OFF) / 4; u += NWAVES * 64) ((LAS unsigned*)(l3 + LDSCTL_OFF))[u] = 0u;
        __syncthreads(); }
    XcdBarrier bar; bar.bar = (unsigned*)((gu32*)(args.ws + WS_CTL) + CW_BAR); bar.x = 0; bar.st = nullptr;
    if (MK_N_LAUNCHES == 1) bar = xcd_barrier_post((unsigned*)((gu32*)(args.ws + WS_CTL) + CW_BAR), (volatile LAS unsigned*)((LAS unsigned char*)lds_raw + MISC_OFF) + 8);
    const int lo = args.ph_lo, hi = args.ph_hi;
#ifndef SITEMASK
#define SITEMASK 0xffff
#endif
#define SITE_ON(s) (((SITEMASK) >> (s)) & 1)
#ifndef MIXMASK
#define MIXMASK 7
#endif
#ifndef PROBE_DUP
#define PROBE_DUP 0
#endif
#ifndef UPV8_MASK
#define UPV8_MASK 3
#endif
#define REPS(s) (1 + (((PROBE_DUP) >> (s)) & 1))
#define IN(k) (lo <= (k) && (k) < hi)
#ifndef PROBE_BAR
#define PROBE_BAR 0
#endif
#define SEAM(k) do { if (IN(k) && IN((k) + 1)) { if (MK_N_LAUNCHES == 1) { xcd_barrier(bar); if (PROBE_BAR) { xcd_barrier(bar); xcd_barrier(bar); } } } } while (0)
#define SITE_VARS() Frame F; make_frame(F, lds_raw); unsigned char* ws = F.ws; const int G = F.G, c = F.c; (void)G; (void)c; \
    float* MOD = (float*)(ws + WS_MOD); bf16* H = (bf16*)(ws + WS_H); bf16* ACT = (bf16*)(ws + WS_ACT); bf16* MG = (bf16*)(ws + WS_MG); bf16* Gt = (bf16*)(ws + WS_G); bf16* U = (bf16*)(ws + WS_U); \
    bf16* YC = (bf16*)(ws + WS_YCAT); bf16* ZT = (bf16*)(ws + WS_ZT); bf16* ZTC = (bf16*)(ws + WS_ZTC); float* X = (float*)(ws + WS_X); \
    unsigned char* wl = ws + WS_WL + (size_t)l * WL_STRIDE; const float* modl = MOD + (size_t)l * 3 * MODW; \
    const float* xs_lat = l == 0 ? F.x : X; const float* xs_ctx = l == 0 ? F.ctx : X + (size_t)TL * DM; \
    (void)H; (void)ACT; (void)MG; (void)Gt; (void)U; (void)YC; (void)ZT; (void)ZTC; (void)X; (void)wl; (void)modl; (void)xs_lat; (void)xs_ctx;

    if (SITE_ON(0) && IN(0)) { for (int rep = 0; rep < REPS(0); ++rep) { Frame F; make_frame(F, lds_raw); phase_prologue(F, rep == 0); __syncthreads(); } }
    SEAM(0);

    for (int l = 0; l < 2; ++l) {
        const int p0 = l == 0 ? 1 : 12;
        const bool last = (l == 1);
        const int nMrows = last ? 64 : 66;

        if (SITE_ON(1) && IN(p0)) {
            { SITE_VARS(); norm_rows(F, xs_lat, xs_ctx, F.g_mix + l * DM, modl, 0, DM, H, T, l == 0 ? nullptr : (const float*)(ws + WS_SLAB), X + (size_t)TL * DM, (unsigned*)(ws + WS_H8), (float*)(ws + WS_SH), l == 0 ? (const float*)(ws + WS_PART) : nullptr, 0); }
            if (l == 0) {
                { SITE_VARS(); const float* part = (const float*)(ws + WS_PART);
                  for (int i = (c * NWAVES + F.wave) * 64 + F.lane; i < 2 * 3 * MODW; i += G * NWAVES * 64) { const int ll = i / (3 * MODW), r = i - ll * 3 * MODW, v = r / MODW, idx = r - v * MODW; MOD[i] = mod_from_parts(part, ll, v, idx); } }
                { Frame F; make_frame(F, lds_raw); quant_gate_weights(F); }
                __syncthreads();
                { SITE_VARS(); pg8::SchedJob S; S.A = (const char*)(ws + WS_WB3T); S.B = (const char*)(ws + WS_WFNETB); S.nZ2 = 1; S.nM = 16; S.nN = 4; S.nTot = 2 * 64; S.hbB = 128L * 1024 * 2;
                  S.az1 = (size_t)DM * 1024 * 2; S.az2 = 0; S.am = (size_t)256 * 1024 * 2; S.bz1 = (size_t)1024 * 1024 * 2; S.bz2 = 0; S.bn = (size_t)256 * 1024 * 2;
                  S.oz1 = (long)(WL_STRIDE / 2); S.oz2 = 0; S.om = (long)256 * DM; S.on = 256;
                  pg8::EpiStore E{(bf16*)(ws + WS_WL + WL_M) + 3072, DM};
                  pg8::gemm_phase<pg8::EpiStore, pg8::SchedJob, true>(F.lds, 1024, 1024, 1024, S, E, G, c); }
                __syncthreads();
                { SITE_VARS(); pg8::SchedJob S; S.A = (const char*)(ws + WS_WB2ST); S.B = (const char*)(ws + WS_WPOOLB); S.nZ2 = 4; S.nM = 16; S.nN = 1; S.nTot = 8 * 16; S.hbB = 128L * 256 * 2;
                  S.az1 = (size_t)DM * 1024 * 2; S.az2 = 256 * 2; S.am = (size_t)256 * 1024 * 2; S.bz1 = (size_t)4 * 65536 * 2; S.bz2 = (size_t)65536 * 2; S.bn = 0;
                  S.oz1 = (long)(WL_STRIDE / 2); S.oz2 = 256; S.om = (long)256 * DM; S.on = 0;
                  pg8::EpiStore E{(bf16*)(ws + WS_WL + WL_M) + 2048, DM};
                  pg8::gemm_phase<pg8::EpiStore, pg8::SchedJob, true>(F.lds, 256, 1024, 256, S, E, G, c); }
            }
        }
        SEAM(p0);

        if (SITE_ON(2) && IN(p0 + 1)) for (int rep = 0; rep < REPS(2); ++rep) {
            SITE_VARS();
            { pg8::SchedRect S; S.A = (const char*)H; S.B = (const char*)(wl + WL_IN); S.nM = last ? 64 : 66; S.nN = 26; S.aS = (size_t)256 * DM * 2; S.bS = (size_t)256 * DM * 2; S.extra = last ? 20 : 0; S.t_c0 = 0; S.t_g = 0;
              pg8::EpiIn E{ACT, Gt, (const float*)(ws + WS_ROPE)};
              pg8::gemm_phase<pg8::EpiIn, pg8::SchedRect, true>(F.lds, DM, DM, DM, S, E, G, c); }
            __syncthreads();
            { SITE_VARS();
              pg8::SchedRect S; S.A = (const char*)(ws + WS_H8); S.B = (const char*)(ws + WS_WG8 + (size_t)l * 16384 * DM); S.nM = last ? 64 : 66; S.nN = 64; S.aS = (size_t)256 * DM; S.bS = (size_t)256 * DM; S.extra = 0; S.t_c0 = 184; S.t_g = (!last && G == 256) ? 72 : 0;
              pg8::EpiGate E{Gt, (const float*)(ws + WS_SH), (const float*)(ws + WS_SW) + l * 16384};
              pg8::gemm_phase<pg8::EpiGate, pg8::SchedRect, true>(F.lds, DM / 2, DM / 2, DM / 2, S, E, G, c); }
        }
        SEAM(p0 + 1);

        if (SITE_ON(3) && IN(p0 + 2)) for (int rep = 0; rep < REPS(3); ++rep) {
            if (MIXMASK & 1) { SITE_VARS(); pg8::SchedS1 S; S.A = (const char*)(ws + WS_TAB1); S.Ub = (const char*)(ACT + OFF_FU);
              pg8::EpiS1 E{ZT};
              pg8::gemm_phase<pg8::EpiS1, pg8::SchedS1, true>(F.lds, 256, 256, ACTW, S, E, G, c); }
            if ((MIXMASK & 1) && !last) { __syncthreads();
              SITE_VARS(); pg8::SchedJob S; S.A = (const char*)(ws + WS_TAB1); S.B = (const char*)(ACT + (size_t)TL * ACTW + OFF_FU); S.nZ2 = 4; S.nM = 2; S.nN = 1; S.nTot = 8 * 2; S.hbB = 128L * ACTW * 2;
              S.az1 = 0; S.az2 = 0; S.am = (size_t)256 * 256 * 2; S.bz1 = (size_t)CTXL * ACTW * 2; S.bz2 = 256 * 2; S.bn = 0;
              S.oz1 = (long)4 * 256 * 512; S.oz2 = (long)256 * 512; S.om = 256; S.on = 0;
              pg8::EpiStore E{ZTC, 512};
              pg8::gemm_phase<pg8::EpiStore, pg8::SchedJob, true>(F.lds, 256, 256, ACTW, S, E, G, G == 256 ? ((c + 192) & 255) : c); }
            __syncthreads();
            if (MIXMASK & 2) { SITE_VARS(); const int NU = last ? 1024 : 1056;
              for (int it = 0; ; ++it) {
                  int L = it * G + c;
                  if (G == 256 && it == 4) L = (c >= 128 && c < 160) ? 1024 + c - 128 : NU;
                  if (L >= NU) break;
                  int kind, b, hh, blk;
                  if (L < 512) { kind = 1; b = L >> 8; hh = (L >> 5) & 7; blk = L & 31; }
                  else if (L < 1024) { const int i = L - 512; kind = 0; b = i >> 8; hh = (i >> 7) & 1; blk = i & 127; }
                  else if (L < 1040) { const int i = L - 1024; kind = 2; b = i >> 3; hh = (i >> 2) & 1; blk = i & 3; }
                  else { const int i = L - 1040; kind = 3; b = i >> 3; hh = i & 7; blk = 0; }
                  att::attn_unit((LAS char*)F.lds, ACT, YC, F.a_sink + l * 8, F.na_rpb + (size_t)l * 8 * 465, kind, b, hh, blk);
              } }
            if (MIXMASK & 4) { SITE_VARS(); pool_diff(F, ACT, YC, last ? TL : T); }
        }
        SEAM(p0 + 2);

        if (SITE_ON(4) && IN(p0 + 3)) for (int rep = 0; rep < REPS(4); ++rep) {
            { SITE_VARS(); pg8::SchedDft S; S.A = (const char*)(ws + WS_DFTA); S.B = (const char*)ZT;
              pg8::EpiF32 E{(float*)(ws + WS_H)};
              pg8::gemm_phase<pg8::EpiF32, pg8::SchedDft, true>(F.lds, pg8::ZK, pg8::ZK, pg8::ZK, S, E, G, c); }
            { SITE_VARS(); dft_specials(F, ZT, YC, (float*)(ws + WS_H + 64 * MiB), ACT, (const bf16*)(ws + WS_TAB1)); }
            if (!last) { __syncthreads();
              SITE_VARS(); pg8::SchedJob S; S.A = (const char*)(ws + WS_DFTC); S.B = (const char*)ZTC; S.nZ2 = 4; S.nM = 1; S.nN = 1; S.nTot = 8; S.hbB = 128L * 512 * 2;
              S.az1 = 0; S.az2 = 0; S.am = 0; S.bz1 = (size_t)4 * 256 * 512 * 2; S.bz2 = (size_t)256 * 512 * 2; S.bn = 0;
              S.oz1 = (long)CTXL * DM; S.oz2 = 256; S.om = 0; S.on = 0;
              pg8::EpiStore E{YC + (size_t)TL * DM + 3072, DM};
              pg8::gemm_phase<pg8::EpiStore, pg8::SchedJob, true>(F.lds, 512, 512, 512, S, E, G, c); }
        }
        SEAM(p0 + 3);

        if (SITE_ON(11) && IN(p0 + 4)) { SITE_VARS(); dft_combine(F, (const float*)(ws + WS_H), (const float*)(ws + WS_H + 64 * MiB), YC); }
        SEAM(p0 + 4);

        if (SITE_ON(5) && IN(p0 + 5)) for (int rep = 0; rep < REPS(5); ++rep) {
            SITE_VARS();
            pg8::SchedSplit S; S.A = (const char*)YC; S.B = (const char*)(wl + WL_M); S.aS = (size_t)256 * DM * 2; S.bS = (size_t)256 * DM * 2; S.pairs = DM / 128; S.nctx = last ? 0 : 256;
            pg8::EpiMerge E{Gt, MG, (float*)(ws + WS_SLAB)};
            pg8::gemm_phase<pg8::EpiMerge, pg8::SchedSplit, true>(F.lds, DM, DM, DM, S, E, G, c);
        }
        SEAM(p0 + 5);

        if (SITE_ON(12) && IN(p0 + 6) && !last) { SITE_VARS(); merge_ctx_sum(F, (const float*)(ws + WS_SLAB), MG); }
        SEAM(p0 + 6);

        if (SITE_ON(6) && IN(p0 + 7)) for (int rep = 0; rep < REPS(6); ++rep) {
            SITE_VARS();
            pg8::SchedSplit S; S.A = (const char*)MG; S.B = (const char*)(wl + WL_OUT); S.aS = (size_t)256 * DM * 2; S.bS = (size_t)256 * DM * 2; S.pairs = DM / 128; S.nctx = last ? 0 : 256;
            pg8::EpiResid E{xs_lat, xs_ctx, (rep + 1 < REPS(6)) ? (float*)(ws + 2800 * MiB) : X, modl + 2 * DM, (float*)(ws + WS_SLAB)};
            pg8::gemm_phase<pg8::EpiResid, pg8::SchedSplit, true>(F.lds, DM, DM, DM, S, E, G, c);
        }
        SEAM(p0 + 7);

        if (SITE_ON(7) && IN(p0 + 8)) for (int rep = 0; rep < REPS(7); ++rep) { SITE_VARS(); norm_rows(F, X, X + (size_t)TL * DM, F.g_ffn + l * DM, modl, 3 * DM, 4 * DM, nullptr, last ? TL : T, last ? nullptr : (const float*)(ws + WS_SLAB), X + (size_t)TL * DM, (unsigned*)(ws + WS_H8), (float*)(ws + WS_SH)); }
        SEAM(p0 + 8);

        if (SITE_ON(8) && IN(p0 + 9)) for (int rep = 0; rep < REPS(8); ++rep) {
            SITE_VARS();
            if (last && rep == 0) { up_tail_rows(F, ws + WS_H8, (const float*)(ws + WS_SH), ws + WS_WGA8, (const float*)(ws + WS_SWUP) + (size_t)l * NUP, F.ff_conv_w + (size_t)l * 3 * DFF, F.ff_conv_b + (size_t)l * DFF, U); }
            pg8::SchedUp S; S.A = (const char*)(ws + WS_H8) - (size_t)DM; S.B = (const char*)(ws + (l == 0 ? WS_WV8 : WS_WGA8)); S.nM = last ? 65 : 68; S.nN = 86; S.aS = (size_t)252 * DM; S.bS = (size_t)256 * DM;
            pg8::EpiUp8 E{U, F.ff_conv_w + (size_t)l * 3 * DFF, F.ff_conv_b + (size_t)l * DFF, (const float*)(ws + WS_SH), (const float*)(ws + WS_SWUP) + (size_t)l * NUP};
            pg8::gemm_phase<pg8::EpiUp8, pg8::SchedUp, true>(F.lds, DM / 2, DM / 2, DM / 2, S, E, G, c);
        }
        SEAM(p0 + 9);

        if (SITE_ON(9) && IN(p0 + 10)) for (int rep = 0; rep < REPS(9); ++rep) {
            SITE_VARS();
            pg8::SchedSplit S; S.A = (const char*)U; S.B = (const char*)(wl + WL_DN); S.aS = (size_t)256 * DFF * 2; S.bS = (size_t)256 * DFF * 2; S.pairs = DFF / 128; S.nctx = last ? 0 : 256;
            pg8::EpiResid E{X, X + (size_t)TL * DM, (rep + 1 < REPS(9)) ? (float*)(ws + 2800 * MiB) : X, modl + 5 * DM, (float*)(ws + WS_SLAB)};
            pg8::gemm_phase<pg8::EpiResid, pg8::SchedSplit, true>(F.lds, DFF, DFF, DFF, S, E, G, c);
        }
        SEAM(p0 + 10);
    }
    if (SITE_ON(10) && IN(23)) { const int l = 1; SITE_VARS(); final_norm(F, X); }
#undef IN
#undef SEAM
}


#ifdef DBG_STOP
__global__ void dbg_dump(const unsigned char* ws, size_t off, int isf32, float* out) {
    const size_t n = (size_t)TL * DM;
    for (size_t i = (size_t)blockIdx.x * blockDim.x + threadIdx.x; i < n; i += (size_t)gridDim.x * blockDim.x)
        out[i] = isf32 ? ((const float*)(ws + off))[i] : bf2f(((const unsigned short*)(ws + off))[i]);
}
#endif
extern "C" void kernel_launch(void* const* d_in, const int* in_sizes, int n_in, void* d_out, int out_size, void* d_ws, size_t ws_size, hipStream_t stream) {
    static int grid = 0;
    if (grid == 0) {
        if (n_in != 22 || ws_size < WS_END) { fprintf(stderr, "kernel_launch: n_in %d ws %zu (need %zu)\n", n_in, ws_size, (size_t)WS_END); grid = -1; return; }
        int dev = 0, cus = 0;
        if (hipGetDevice(&dev) != hipSuccess || hipDeviceGetAttribute(&cus, hipDeviceAttributeMultiprocessorCount, dev) != hipSuccess) { grid = -1; return; }
        if (hipFuncSetAttribute((const void*)fwd, hipFuncAttributeMaxDynamicSharedMemorySize, LDS_BYTES) != hipSuccess) { fprintf(stderr, "kernel_launch: hipFuncSetAttribute failed\n"); grid = -1; return; }
        int per_cu = 0; (void)hipOccupancyMaxActiveBlocksPerMultiprocessor(&per_cu, (const void*)fwd, NWAVES * 64, LDS_BYTES); (void)hipGetLastError();
        grid = cus;
    }
    if (grid < 0) return;
    (void)hipMemsetAsync((char*)d_ws + WS_CTL, 0, CTL_ZERO_BYTES, stream);
    Args a{};
    for (int i = 0; i < 22; ++i) a.in[i] = (const float*)d_in[i];
    a.out = (float*)d_out; a.ws = (unsigned char*)d_ws;
#ifdef DBG_STOP
    for (int p = 0; p < DBG_STOP; ++p) { a.ph_lo = p; a.ph_hi = p + 1; hipLaunchKernelGGL(fwd, dim3(grid), dim3(NWAVES * 64), LDS_BYTES, stream, a); }
    hipLaunchKernelGGL(dbg_dump, dim3(2048), dim3(256), 0, stream, (const unsigned char*)d_ws, (size_t)DBG_OFF, (int)DBG_F32, (float*)d_out);
    return;
#endif
    if (MK_N_LAUNCHES == 1) { a.ph_lo = 0; a.ph_hi = N_PHASES; hipLaunchKernelGGL(fwd, dim3(grid), dim3(NWAVES * 64), LDS_BYTES, stream, a); }
    else { for (int p = 0; p < N_PHASES; ++p) { a.ph_lo = p; a.ph_hi = p + 1; hipLaunchKernelGGL(fwd, dim3(grid), dim3(NWAVES * 64), LDS_BYTES, stream, a); } }
}
```
